# Optimizing an MI355X kernel written in HIP

```python
import math
import jax, jax.numpy as jnp
from jax import lax
import numpy as np

D_MODEL = 1024
BATCH = 8
SEQ = 4096
DEPTH = 1

HEAD_DIM = 64
POOL_WIDTH = D_MODEL // 4
POOL_WINDOWS = (2, 4, 8, 16)
POOL_GROUPS = len(POOL_WINDOWS)
POOL_GROUP_DIM = POOL_WIDTH // POOL_GROUPS
ATTN_WIDTH = D_MODEL - POOL_WIDTH
ATTN_HEADS = ATTN_WIDTH // HEAD_DIM
DILATION_CFG = ((128, 1), (512, 4), (2048, 16))
N_DIL = len(DILATION_CFG)
HEADS_PER_DIL = ATTN_HEADS // N_DIL
ATTN_OUT_WIDTH = HEADS_PER_DIL * HEAD_DIM
IN_PROJ_WIDTH = POOL_WIDTH + 3 * ATTN_WIDTH
OUT_PROJ_WIDTH = POOL_WIDTH + ATTN_OUT_WIDTH
ROT_DIM = HEAD_DIM // 4
ROPE_THETA = 500000.0
D_FF = 11 * D_MODEL // 4
CONV_WIDTH = 3
BLOCK = 128
NORM_EPS = 1e-6
N_MOD = 6

kernel_name = "hybrid_pool_dilated_attn_convffn_block"


def rms_norm(x, g):
    x32 = x.astype(jnp.float32)
    y = x32 * lax.rsqrt(jnp.mean(x32 * x32, axis=-1, keepdims=True) + NORM_EPS)
    return (y * g.astype(jnp.float32)).astype(x.dtype)


def partial_rope(t, cos, sin):
    half = ROT_DIM // 2
    t1 = t[..., :half]
    t2 = t[..., half:ROT_DIM]
    return jnp.concatenate(
        [t1 * cos - t2 * sin, t2 * cos + t1 * sin, t[..., ROT_DIM:]], axis=-1)


def causal_multiscale_pool(u, w_pool, b_pool, pool_scale):
    B, S, _ = u.shape
    u32 = u.astype(jnp.float32).reshape(B, S, POOL_GROUPS, POOL_GROUP_DIM)
    cs = jnp.cumsum(u32, axis=1)
    t = jnp.arange(S, dtype=jnp.float32)
    means = []
    for gi, w in enumerate(POOL_WINDOWS):
        csg = cs[:, :, gi]
        lagged = jnp.pad(csg[:, :S - w], ((0, 0), (w, 0), (0, 0)))
        count = jnp.minimum(t + 1.0, float(w))
        means.append((csg - lagged) / count[None, :, None])
    mixed = jnp.stack(means, axis=2) - u32
    y = jnp.einsum('bsgc,gcd->bsgd', mixed, w_pool.astype(jnp.float32)) + b_pool.astype(jnp.float32)
    return (y.reshape(B, S, POOL_WIDTH) * pool_scale.astype(jnp.float32)).astype(u.dtype)


def dilated_window_attention(q, k, v, window, dilation):
    B, S, H, hd = q.shape
    span = window // dilation
    assert span <= BLOCK
    chunk = dilation * BLOCK
    s_pad = -(-S // chunk) * chunk
    padw = ((0, 0), (0, s_pad - S), (0, 0), (0, 0))
    q, k, v = (jnp.pad(a.astype(jnp.float32), padw) for a in (q, k, v))
    nb = s_pad // chunk
    qb, kb, vb = (a.reshape(B, nb, BLOCK, dilation, H, hd) for a in (q, k, v))

    def with_prev(a):
        prev = jnp.pad(a[:, :-1], ((0, 0), (1, 0), (0, 0), (0, 0), (0, 0), (0, 0)))
        return jnp.concatenate([prev, a], axis=2)

    kk, vv = with_prev(kb), with_prev(vb)
    scores = jnp.einsum('bnirhd,bnjrhd->bnrhij', qb, kk)
    i = jnp.arange(BLOCK)[:, None]
    j = jnp.arange(2 * BLOCK)[None, :]
    n = jnp.arange(nb)[:, None, None]
    dist = BLOCK + i - j
    valid = (dist >= 0) & (dist <= span) & (n * BLOCK + j - BLOCK >= 0)
    scores = jnp.where(valid[None, :, None, None], scores, -jnp.inf)
    m = jnp.max(scores, axis=-1, keepdims=True)
    p = jnp.exp(scores - m)
    den = jnp.sum(p, axis=-1)
    o = jnp.einsum('bnrhij,bnjrhd->bnirhd', p, vv)
    den_t = jnp.moveaxis(den, -1, 2)
    lse_t = jnp.moveaxis(m[..., 0] + jnp.log(den), -1, 2)
    o = (o / den_t[..., None]).reshape(B, s_pad, H, hd)[:, :S]
    lse = lse_t.reshape(B, s_pad, H)[:, :S]
    return o, lse


def mixing_sublayer(h, cos, sin, w_in, w_pool, b_pool, pool_scale, w_out):
    B, S, _ = h.shape
    proj = h @ w_in
    u_pool = proj[..., :POOL_WIDTH]
    qkv = proj[..., POOL_WIDTH:].reshape(B, S, 3, ATTN_HEADS, HEAD_DIM)
    q = partial_rope(qkv[:, :, 0], cos, sin) * (HEAD_DIM ** -0.5)
    k = partial_rope(qkv[:, :, 1], cos, sin)
    v = qkv[:, :, 2]
    outs, lses = [], []
    for g, (window, dilation) in enumerate(DILATION_CFG):
        sl = slice(g * HEADS_PER_DIL, (g + 1) * HEADS_PER_DIL)
        o, l = dilated_window_attention(q[:, :, sl], k[:, :, sl], v[:, :, sl], window, dilation)
        outs.append(o)
        lses.append(l)
    alpha = jax.nn.softmax(jnp.stack(lses, axis=0), axis=0)
    attn = jnp.sum(alpha[..., None] * jnp.stack(outs, axis=0), axis=0)
    attn = attn.reshape(B, S, ATTN_OUT_WIDTH).astype(h.dtype)
    pool = causal_multiscale_pool(u_pool, w_pool, b_pool, pool_scale)
    return jnp.concatenate([pool, attn], axis=-1) @ w_out


def conv_ffn(h, w_up, conv_w, conv_b, w_down):
    S = h.shape[1]
    up = h @ w_up
    gate, val = up[..., :D_FF], up[..., D_FF:]
    gp = jnp.pad(gate, ((0, 0), (CONV_WIDTH - 1, 0), (0, 0)))
    gate = gp[:, 0:S] * conv_w[0] + gp[:, 1:S + 1] * conv_w[1] + gp[:, 2:S + 2] * conv_w[2] + conv_b
    return (jax.nn.gelu(gate, approximate=True) * val) @ w_down


def setup_inputs(seed: int = 0) -> dict:
    key = jax.random.key(seed)
    ks = jax.random.split(key, 20)
    f32 = jnp.float32
    nrm = lambda k, shape, s: jax.random.normal(k, shape, f32) * s
    L = DEPTH
    return {
        "x": nrm(ks[0], (BATCH, SEQ, D_MODEL), 1.0),
        "c": nrm(ks[1], (BATCH, D_MODEL), 1.0),
        "positions": jnp.broadcast_to(jnp.arange(SEQ, dtype=jnp.int32), (BATCH, SEQ)),
        "w_ada": nrm(ks[2], (L, D_MODEL, N_MOD * D_MODEL), D_MODEL ** -0.5),
        "b_ada": nrm(ks[3], (L, N_MOD * D_MODEL), 0.02),
        "g_pre_mix": 1.0 + nrm(ks[4], (L, D_MODEL), 0.05),
        "g_post_mix": 1.0 + nrm(ks[5], (L, D_MODEL), 0.05),
        "g_pre_ffn": 1.0 + nrm(ks[6], (L, D_MODEL), 0.05),
        "g_post_ffn": 1.0 + nrm(ks[7], (L, D_MODEL), 0.05),
        "w_in": nrm(ks[8], (L, D_MODEL, IN_PROJ_WIDTH), D_MODEL ** -0.5),
        "w_pool": nrm(ks[9], (L, POOL_GROUPS, POOL_GROUP_DIM, POOL_GROUP_DIM), POOL_GROUP_DIM ** -0.5),
        "b_pool": nrm(ks[10], (L, POOL_GROUPS, POOL_GROUP_DIM), 0.02),
        "pool_scale": 1.0 + nrm(ks[11], (L, POOL_WIDTH), 0.05),
        "w_out": nrm(ks[12], (L, OUT_PROJ_WIDTH, D_MODEL), OUT_PROJ_WIDTH ** -0.5),
        "w_up": nrm(ks[13], (L, D_MODEL, 2 * D_FF), D_MODEL ** -0.5),
        "conv_w": nrm(ks[14], (L, CONV_WIDTH, D_FF), CONV_WIDTH ** -0.5),
        "conv_b": nrm(ks[15], (L, D_FF), 0.02),
        "w_down": nrm(ks[16], (L, D_FF, D_MODEL), D_FF ** -0.5),
    }


def reference(x, c, positions, w_ada, b_ada, g_pre_mix, g_post_mix, g_pre_ffn, g_post_ffn,
              w_in, w_pool, b_pool, pool_scale, w_out, w_up, conv_w, conv_b, w_down):
    inv_freq = ROPE_THETA ** (-jnp.arange(0, ROT_DIM, 2, dtype=jnp.float32) / ROT_DIM)
    ang = positions.astype(jnp.float32)[..., None] * inv_freq
    cos = jnp.cos(ang)[:, :, None, :].astype(x.dtype)
    sin = jnp.sin(ang)[:, :, None, :].astype(x.dtype)
    c_act = jax.nn.silu(c)
    for l in range(DEPTH):
        mod = c_act @ w_ada[l] + b_ada[l]
        sh_m, sc_m, gt_m, sh_f, sc_f, gt_f = (t[:, None, :] for t in jnp.split(mod, N_MOD, axis=-1))
        h = rms_norm(x, g_pre_mix[l]) * (1.0 + sc_m) + sh_m
        y = mixing_sublayer(h, cos, sin, w_in[l], w_pool[l], b_pool[l], pool_scale[l], w_out[l])
        x = x + gt_m * rms_norm(y, g_post_mix[l])
        h = rms_norm(x, g_pre_ffn[l]) * (1.0 + sc_f) + sh_f
        y = conv_ffn(h, w_up[l], conv_w[l], conv_b[l], w_down[l])
        x = x + gt_f * rms_norm(y, g_post_ffn[l])
    return x
```

```cpp
#include <hip/hip_runtime.h>
#include <cstdio>
#include <cstdint>

#ifndef MK_ONE_LAUNCH
#define MK_ONE_LAUNCH 0
#endif

constexpr int BATCH = 8, SEQ = 4096, D = 1024, M = BATCH * SEQ;
constexpr int POOLW = 256, AW = 768, NH = 12, HD = 64, NIN = 2560, NMIX = 512, DFF = 2816, NUP = 2 * DFF, NMOD = 6 * D;
constexpr float NORM_EPS = 1e-6f;
constexpr float QSCALE = 0.125f * 1.4426950408889634f;
constexpr int NPHASE = 9;

constexpr size_t MiB = 1u << 20;
constexpr size_t WS_CTL = 0, CTL_ZERO_BYTES = 1 * MiB;
constexpr size_t WS_MOD = 1 * MiB;
constexpr size_t WS_ROPE = 2 * MiB;
constexpr size_t WS_WIN = 4 * MiB, WS_WOUT = 9 * MiB, WS_WUP = 10 * MiB, WS_WDOWN = 21 * MiB;
constexpr size_t WS_XN = 32 * MiB;
constexpr size_t WS_U = 96 * MiB;
constexpr size_t WS_Q = 112 * MiB, WS_K = 160 * MiB, WS_V = 208 * MiB;
constexpr size_t WS_MIX = 256 * MiB;
constexpr size_t WS_Y = 288 * MiB;
constexpr size_t WS_ACT = 96 * MiB;
constexpr size_t WS_END = 352 * MiB;
constexpr int CW_TMO = 0, CW_CODE = 1, CW_BAR = 4096;

constexpr int RING_OFF = 0, RING_BYTES = 131072;
constexpr int LDSCTL_OFF = RING_BYTES, MISC_OFF = LDSCTL_OFF + 320;
constexpr int LDS_BYTES = 147456;
constexpr int NWAVES = 8;

#define GAS __attribute__((address_space(1)))
#define LAS __attribute__((address_space(3)))
typedef unsigned short bf16;
typedef unsigned v4u __attribute__((ext_vector_type(4)));
typedef unsigned v2u __attribute__((ext_vector_type(2)));
typedef float f32x4 __attribute__((ext_vector_type(4)));
typedef short bf16x8 __attribute__((ext_vector_type(8)));
typedef GAS unsigned gu32;
#define RLX_AGENT __ATOMIC_RELAXED, __HIP_MEMORY_SCOPE_AGENT
#define LDS_WAIT() asm volatile("s_waitcnt lgkmcnt(0)" ::: "memory")
#define VM_WAIT() asm volatile("s_waitcnt vmcnt(0)" ::: "memory")

__device__ __forceinline__ unsigned f2bf(float f) { unsigned u = __builtin_bit_cast(unsigned, f); return (u + 0x7fffu + ((u >> 16) & 1u)) >> 16; }
__device__ __forceinline__ unsigned pk2(float lo, float hi) { return f2bf(lo) | (f2bf(hi) << 16); }
__device__ __forceinline__ float bf2f(unsigned short h) { return __builtin_bit_cast(float, (unsigned)h << 16); }
__device__ __forceinline__ float bflo(unsigned w) { return __builtin_bit_cast(float, w << 16); }
__device__ __forceinline__ float bfhi(unsigned w) { return __builtin_bit_cast(float, w & 0xffff0000u); }

#define XB_TMO      128
#define XB_XCNT(j)  (256  + 64 * (j))
#define XB_XSUB(j)  (1280 + 64 * (j))
#define XB_XGEN(j)  (2304 + 64 * (j))
#define XB_TOP      3328
#define XB_TOPGEN   3392
#define XCD_BAR_WORDS 3456
#define XB_SPIN_CAP (1u << 18)
__device__ __forceinline__ unsigned xb_ld(unsigned* p)              { return __hip_atomic_load(p, __ATOMIC_RELAXED, __HIP_MEMORY_SCOPE_AGENT); }
__device__ __forceinline__ unsigned xb_add(unsigned* p, unsigned v) { return __hip_atomic_fetch_add(p, v, __ATOMIC_RELAXED, __HIP_MEMORY_SCOPE_AGENT); }
__device__ __forceinline__ unsigned xb_xcc_id() { return (unsigned)__builtin_amdgcn_s_getreg((3 << 11) | 20) & 0xFu; }
#define XB_SPIN(cond, bar) do { unsigned _sp = 0; while (cond) { __builtin_amdgcn_s_sleep(1); \
    if ((++_sp & 255u) == 0u) { if (xb_ld(&(bar)[XB_TMO])) break; if (_sp > XB_SPIN_CAP) { atomicAdd(&(bar)[XB_TMO], 1u); break; } } } } while (0)
struct XcdBarrier { unsigned* bar; unsigned x; volatile LAS unsigned* st; };
__device__ __forceinline__ XcdBarrier xcd_barrier_post(unsigned* bar, volatile LAS unsigned* st) {
    XcdBarrier b; b.bar = bar; b.x = xb_xcc_id(); b.st = st;
    if (threadIdx.x == 0) (void)xb_add(&bar[XB_XCNT(b.x)], 1u);
    return b;
}
__device__ __forceinline__ void xcd_barrier_complete(unsigned* bar, unsigned x, unsigned& nloc, unsigned& nx) {
    const unsigned G = gridDim.x * gridDim.y * gridDim.z;
    unsigned sum, cnt, mine, sp = 0u;
    for (;;) {
        sum = 0u; cnt = 0u; mine = 0u;
#pragma unroll
        for (unsigned j = 0; j < 16; ++j) { const unsigned c = xb_ld(&bar[XB_XCNT(j)]); sum += c; cnt += (c > 0u) ? 1u : 0u; mine = (j == x) ? c : mine; }
        if (sum == G) break;
        __builtin_amdgcn_s_sleep(1);
        if ((++sp & 255u) == 0u) { if (xb_ld(&bar[XB_TMO])) break; if (sp > XB_SPIN_CAP) { atomicAdd(&bar[XB_TMO], 1u); break; } }
    }
    nloc = mine > 0u ? mine : 1u; nx = cnt > 0u ? cnt : 1u;
}
__device__ __forceinline__ void xcd_barrier(const XcdBarrier& b) {
    asm volatile("s_waitcnt vmcnt(0)" ::: "memory");
    __syncthreads();
    if (threadIdx.x == 0) {
        unsigned* bar = b.bar;
        __builtin_amdgcn_s_waitcnt(0);
        unsigned nloc = b.st[0], nx = b.st[1];
        if (nloc == 0u) { xcd_barrier_complete(bar, b.x, nloc, nx); b.st[0] = nloc; b.st[1] = nx; }
        const unsigned old = xb_add(&bar[XB_XSUB(b.x)], 1u);
        const unsigned gen = old / nloc;
        if (old + 1u == (gen + 1u) * nloc) {
            __builtin_amdgcn_fence(__ATOMIC_RELEASE, "agent");
            asm volatile("s_waitcnt vmcnt(0)" ::: "memory");
            const unsigned og = xb_add(&bar[XB_TOP], 1u);
            const unsigned tg = og / nx;
            if (og + 1u == (tg + 1u) * nx) xb_add(&bar[XB_TOPGEN], 1u);
            else XB_SPIN(xb_ld(&bar[XB_TOPGEN]) == tg, bar);
            __builtin_amdgcn_fence(__ATOMIC_ACQUIRE, "agent");
            xb_add(&bar[XB_XGEN(b.x)], 1u);
            asm volatile("s_waitcnt vmcnt(0)" ::: "memory");
        } else {
            XB_SPIN(xb_ld(&bar[XB_XGEN(b.x)]) == gen, bar);
            __builtin_amdgcn_fence(__ATOMIC_ACQUIRE, "agent");
            asm volatile("s_waitcnt vmcnt(0)" ::: "memory");
        }
    }
    __syncthreads();
}

struct Frame {
    LAS unsigned char* lds;
    volatile LAS unsigned* MISC;
    gu32* ctl;
    int tid, lane, wave;
    int vcu, G;
    const float* x; const float* c; const int* pos; const float* w_ada; const float* b_ada;
    const float *g_pre_mix, *g_post_mix, *g_pre_ffn, *g_post_ffn;
    const float *w_in, *w_pool, *b_pool, *pool_scale, *w_out, *w_up, *conv_w, *conv_b, *w_down;
    float* out;
    float* MOD; float* ROPE;
    bf16 *WIN, *WOUT, *WUP, *WDOWN;
    bf16 *XN, *U, *Q, *K, *V, *MIX, *Y, *ACT;
};

__device__ __forceinline__ float wave_sum(float v) {
#pragma unroll
    for (int o = 1; o < 64; o <<= 1) v += __shfl_xor(v, o);
    return v;
}
__device__ __forceinline__ float wave_max(float v) {
#pragma unroll
    for (int o = 1; o < 64; o <<= 1) v = fmaxf(v, __shfl_xor(v, o));
    return v;
}

template <int MODE> __device__ __forceinline__ int rowmap(int n) {
    if (MODE == 0) return n;
    if (n < DFF) return 256 * (n >> 7) + (n & 127);
    const int m = n - DFF; return 256 * (m >> 7) + 128 + (m & 127);
}
template <int MODE> __device__ __forceinline__ void p0_transpose_item(const float* W, int K, int N, bf16* WT, LAS float* scr, int item, int lane) {
    const int nblk = N / 32, kb = item / nblk, nb = item % nblk, k0 = 64 * kb, n0 = 32 * nb;
#pragma unroll 8
    for (int i = 0; i < 32; ++i) { const int kk = 2 * i + (lane >> 5); scr[kk * 33 + (lane & 31)] = W[(size_t)(k0 + kk) * N + n0 + (lane & 31)]; }
    LDS_WAIT(); asm volatile("" ::: "memory");
    const int c = lane & 7; const int r0 = rowmap<MODE>(n0);
#pragma unroll
    for (int j = 0; j < 4; ++j) { const int n = (lane >> 3) + 8 * j; const LAS float* s = scr + (8 * c) * 33 + n;
        v4u o; o.x = pk2(s[0 * 33], s[1 * 33]); o.y = pk2(s[2 * 33], s[3 * 33]); o.z = pk2(s[4 * 33], s[5 * 33]); o.w = pk2(s[6 * 33], s[7 * 33]);
        *(GAS v4u*)(WT + (size_t)(r0 + n) * K + k0 + 8 * c) = o; }
    LDS_WAIT(); asm volatile("" ::: "memory");
}
__constant__ float INV_FREQ[8] = {1.0f, 0.1939227432012558f, 0.03760603070259094f, 0.007292664609849453f, 0.0014142135623842478f,
                                  0.00027424818836152554f, 5.3182957344688475e-05f, 1.0313385246263351e-05f};
__device__ __forceinline__ void p0a_phase(Frame& F) {
    LAS float* cact = (LAS float*)(F.lds + RING_OFF);
    LAS float* red = (LAS float*)(F.lds + RING_OFF + 32768);
    if (F.vcu < NMOD / 64) {
        for (int i = F.tid; i < BATCH * D; i += NWAVES * 64) { const float v = F.c[i]; cact[i] = v / (1.0f + __expf(-v)); }
        __syncthreads();
        const int n = F.vcu * 64 + F.lane; float acc[BATCH];
#pragma unroll
        for (int b = 0; b < BATCH; ++b) acc[b] = 0.f;
        const int k0 = F.wave * (D / NWAVES);
#pragma unroll 4
        for (int k = k0; k < k0 + D / NWAVES; ++k) { const float w = F.w_ada[(size_t)k * NMOD + n];
#pragma unroll
            for (int b = 0; b < BATCH; ++b) acc[b] += cact[b * D + k] * w; }
#pragma unroll
        for (int b = 0; b < BATCH; ++b) red[(F.wave * BATCH + b) * 64 + F.lane] = acc[b];
        __syncthreads();
        { const int b = F.wave; float s = F.b_ada[n];
#pragma unroll
          for (int w = 0; w < NWAVES; ++w) s += red[(w * BATCH + b) * 64 + F.lane];
          F.MOD[b * NMOD + n] = s; }
        __syncthreads();
    }
    LAS float* scr = (LAS float*)(F.lds + RING_OFF + F.wave * 16384);
    const int gw = F.vcu * NWAVES + F.wave, NGW = F.G * NWAVES;
    constexpr int I_IN = (D / 64) * (NIN / 32), I_OUT = (NMIX / 64) * (D / 32), I_UP = (D / 64) * (NUP / 32), I_DOWN = (DFF / 64) * (D / 32);
    constexpr int NITEMS = I_IN + I_OUT + I_UP + I_DOWN;
    for (int it = NGW - 1 - gw; it < NITEMS; it += NGW) {
        int r = it;
        if (r < I_IN) { p0_transpose_item<0>(F.w_in, D, NIN, F.WIN, scr, r, F.lane); continue; } r -= I_IN;
        if (r < I_OUT) { p0_transpose_item<0>(F.w_out, NMIX, D, F.WOUT, scr, r, F.lane); continue; } r -= I_OUT;
        if (r < I_UP) { p0_transpose_item<1>(F.w_up, D, NUP, F.WUP, scr, r, F.lane); continue; } r -= I_UP;
        p0_transpose_item<0>(F.w_down, DFF, D, F.WDOWN, scr, r, F.lane);
    }
    const int gt = (F.vcu * NWAVES + F.wave) * 64 + F.lane, NGT = NGW * 64;
    for (int idx = gt; idx < M * 8; idx += NGT) { const int row = idx >> 3, j = idx & 7;
        const float ang = (float)F.pos[row] * INV_FREQ[j];
        double rev = (double)ang * 0.15915494309189535; rev -= __builtin_rint(rev);
        const float rf = (float)rev;
        F.ROPE[row * 16 + j] = __builtin_amdgcn_cosf(rf); F.ROPE[row * 16 + 8 + j] = __builtin_amdgcn_sinf(rf); }
}

__device__ __forceinline__ void p0b_phase(Frame& F) {
    const int gw = F.vcu * NWAVES + F.wave, NGW = F.G * NWAVES;
    for (int m = gw; m < M; m += NGW) {
        const int b = m / SEQ; const float* mod = F.MOD + b * NMOD;
        const GAS f32x4* xr = (const GAS f32x4*)(F.x + (size_t)m * D) + F.lane;
        f32x4 v[4]; float s = 0.f;
#pragma unroll
        for (int j = 0; j < 4; ++j) { v[j] = xr[64 * j]; s += (v[j].x * v[j].x + v[j].y * v[j].y) + (v[j].z * v[j].z + v[j].w * v[j].w); }
        const float rstd = 1.0f / sqrtf(wave_sum(s) * (1.f / D) + NORM_EPS);
        GAS v2u* o8 = (GAS v2u*)(F.XN + (size_t)m * D) + F.lane;
#pragma unroll
        for (int j = 0; j < 4; ++j) { const int col = 4 * F.lane + 256 * j;
            const f32x4 g = *(const f32x4*)(F.g_pre_mix + col), sh = *(const f32x4*)(mod + col), sc = *(const f32x4*)(mod + D + col);
            const f32x4 h = v[j] * rstd * g * (sc + 1.0f) + sh;
            v2u w; w.x = pk2(h.x, h.y); w.y = pk2(h.z, h.w); o8[64 * j] = w; }
    }
}
__device__ __forceinline__ void norm1_phase(Frame& F) {
    const int gw = F.vcu * NWAVES + F.wave, NGW = F.G * NWAVES;
    for (int m = gw; m < M; m += NGW) {
        const int b = m / SEQ; const float* mod = F.MOD + b * NMOD;
        const GAS f32x4* xr = (const GAS f32x4*)(F.x + (size_t)m * D) + F.lane;
        const GAS v2u* yr = (const GAS v2u*)(F.Y + (size_t)m * D) + F.lane;
        f32x4 y[4]; float s = 0.f;
#pragma unroll
        for (int j = 0; j < 4; ++j) { const v2u w = yr[64 * j]; y[j] = (f32x4){bflo(w.x), bfhi(w.x), bflo(w.y), bfhi(w.y)};
            s += (y[j].x * y[j].x + y[j].y * y[j].y) + (y[j].z * y[j].z + y[j].w * y[j].w); }
        const float rstd = 1.0f / sqrtf(wave_sum(s) * (1.f / D) + NORM_EPS);
        f32x4 x1[4]; float s2 = 0.f;
        GAS f32x4* orow = (GAS f32x4*)(F.out + (size_t)m * D) + F.lane;
#pragma unroll
        for (int j = 0; j < 4; ++j) { const int col = 4 * F.lane + 256 * j;
            const f32x4 g = *(const f32x4*)(F.g_post_mix + col), gt = *(const f32x4*)(mod + 2 * D + col);
            x1[j] = xr[64 * j] + gt * (y[j] * rstd * g); orow[64 * j] = x1[j];
            s2 += (x1[j].x * x1[j].x + x1[j].y * x1[j].y) + (x1[j].z * x1[j].z + x1[j].w * x1[j].w); }
        const float rstd2 = 1.0f / sqrtf(wave_sum(s2) * (1.f / D) + NORM_EPS);
        GAS v2u* o8 = (GAS v2u*)(F.XN + (size_t)m * D) + F.lane;
#pragma unroll
        for (int j = 0; j < 4; ++j) { const int col = 4 * F.lane + 256 * j;
            const f32x4 g = *(const f32x4*)(F.g_pre_ffn + col), sh = *(const f32x4*)(mod + 3 * D + col), sc = *(const f32x4*)(mod + 4 * D + col);
            const f32x4 h = x1[j] * rstd2 * g * (sc + 1.0f) + sh;
            v2u w; w.x = pk2(h.x, h.y); w.y = pk2(h.z, h.w); o8[64 * j] = w; }
    }
}
__device__ __forceinline__ void norm2_phase(Frame& F) {
    const int gw = F.vcu * NWAVES + F.wave, NGW = F.G * NWAVES;
    for (int m = gw; m < M; m += NGW) {
        const int b = m / SEQ; const float* mod = F.MOD + b * NMOD;
        const GAS v2u* yr = (const GAS v2u*)(F.Y + (size_t)m * D) + F.lane;
        f32x4 y[4]; float s = 0.f;
#pragma unroll
        for (int j = 0; j < 4; ++j) { const v2u w = yr[64 * j]; y[j] = (f32x4){bflo(w.x), bfhi(w.x), bflo(w.y), bfhi(w.y)};
            s += (y[j].x * y[j].x + y[j].y * y[j].y) + (y[j].z * y[j].z + y[j].w * y[j].w); }
        const float rstd = 1.0f / sqrtf(wave_sum(s) * (1.f / D) + NORM_EPS);
        GAS f32x4* orow = (GAS f32x4*)(F.out + (size_t)m * D) + F.lane;
#pragma unroll
        for (int j = 0; j < 4; ++j) { const int col = 4 * F.lane + 256 * j;
            const f32x4 g = *(const f32x4*)(F.g_post_ffn + col), gt = *(const f32x4*)(mod + 5 * D + col);
            orow[64 * j] = orow[64 * j] + gt * (y[j] * rstd * g); }
    }
}

template <class Epi> __device__ __forceinline__ void sgemm_phase(Frame& F, const bf16* A, const bf16* Bt, int Mr, int N, int K, const Epi& E) {
    const int gw = F.vcu * NWAVES + F.wave, NGW = F.G * NWAVES;
    const int ntn = N / 64, nit = (Mr / 16) * ntn;
    const int lr = F.lane & 15, kq = (F.lane >> 4) * 8;
    for (int it = gw; it < nit; it += NGW) {
        const int rt = it / ntn, ct = it % ntn;
        const bf16* ap = A + (size_t)(rt * 16 + lr) * K + kq;
        const bf16* bp = Bt + (size_t)(ct * 64 + lr) * K + kq;
        f32x4 acc[4];
#pragma unroll
        for (int j = 0; j < 4; ++j) acc[j] = (f32x4){0.f, 0.f, 0.f, 0.f};
#pragma unroll 4
        for (int k0 = 0; k0 < K; k0 += 32) {
            const bf16x8 a = *(const bf16x8*)(ap + k0);
#pragma unroll
            for (int j = 0; j < 4; ++j) { const bf16x8 bv = *(const bf16x8*)(bp + (size_t)(16 * j) * K + k0);
                acc[j] = __builtin_amdgcn_mfma_f32_16x16x32_bf16(a, bv, acc[j], 0, 0, 0); }
        }
        E(acc, rt, ct, F.lane);
    }
}
struct SEpiStore { bf16* O; int ldc;
    __device__ __forceinline__ void operator()(const f32x4 (&acc)[4], int rt, int ct, int lane) const {
#pragma unroll
        for (int e = 0; e < 4; ++e) { const int row = rt * 16 + (lane >> 4) * 4 + e;
#pragma unroll
            for (int j = 0; j < 4; ++j) O[(size_t)row * ldc + ct * 64 + 16 * j + (lane & 15)] = (bf16)f2bf(acc[j][e]); }
    }
};
__device__ __forceinline__ int prow_of(int s, int sh) { return ((s & ((1 << sh) - 1)) << (12 - sh)) + (s >> sh); }
struct SEpiQKV { bf16 *U, *Q, *K, *V; const float* rope;
    __device__ __forceinline__ void operator()(const f32x4 (&acc)[4], int rt, int ct, int lane) const {
        const int col0 = ct * 64;
        if (col0 < POOLW) {
#pragma unroll
            for (int e = 0; e < 4; ++e) { const int row = rt * 16 + (lane >> 4) * 4 + e;
#pragma unroll
                for (int j = 0; j < 4; ++j) U[(size_t)row * POOLW + col0 + 16 * j + (lane & 15)] = (bf16)f2bf(acc[j][e]); }
            return;
        }
        const int c = col0 - POOLW, part = c / AW, hh = (c % AW) / HD, sh = 2 * (hh >> 2);
        bf16* dst = Q + (size_t)part * ((WS_K - WS_Q) / 2);
#pragma unroll
        for (int e = 0; e < 4; ++e) { const int row = rt * 16 + (lane >> 4) * 4 + e, b = row / SEQ, s = row % SEQ;
            const size_t base = ((size_t)(b * NH + hh) * SEQ + prow_of(s, sh)) * HD;
#pragma unroll
            for (int j = 0; j < 4; ++j) { const int dd = 16 * j + (lane & 15); float v = acc[j][e];
                if (j == 0 && part < 2) { const float partner = __shfl_xor(v, 8); const int jj = dd & 7;
                    const float cs = rope[row * 16 + jj], sn = rope[row * 16 + 8 + jj];
                    v = (dd < 8) ? (v * cs - partner * sn) : (v * cs + partner * sn); }
                if (part == 0) v *= QSCALE;
                dst[base + dd] = (bf16)f2bf(v); } }
    }
};
__device__ __forceinline__ float gelu_tanh(float x) {
    const float u = 0.7978845608028654f * (x + 0.044715f * x * x * x);
    const float t = 1.0f - 2.0f / (__expf(2.0f * u) + 1.0f);
    return 0.5f * x * (1.0f + t);
}
__device__ __forceinline__ void sgemm_up_phase(Frame& F) {
    const int gw = F.vcu * NWAVES + F.wave, NGW = F.G * NWAVES;
    constexpr int ntn = DFF / 16, nit = (M / 16) * ntn, K = D;
    const int lr = F.lane & 15, kq = (F.lane >> 4) * 8;
    for (int it = gw; it < nit; it += NGW) {
        const int rt = it / ntn, ct = it % ntn;
        const int arow = rt * 16 + lr, as = arow % SEQ;
        const bf16* ap = F.XN + (size_t)arow * K + kq;
        const int gcol = ct * 16 + lr;
        const bf16* bg = F.WUP + (size_t)(256 * (gcol >> 7) + (gcol & 127)) * K + kq;
        const bf16* bv = bg + (size_t)128 * K;
        f32x4 g0 = {0.f, 0.f, 0.f, 0.f}, g1 = g0, g2 = g0, vv = g0;
        const bf16x8 zero = {0, 0, 0, 0, 0, 0, 0, 0};
#pragma unroll 2
        for (int k0 = 0; k0 < K; k0 += 32) {
            const bf16x8 a0 = *(const bf16x8*)(ap + k0);
            const bf16x8 a1 = as >= 1 ? *(const bf16x8*)(ap - K + k0) : zero;
            const bf16x8 a2 = as >= 2 ? *(const bf16x8*)(ap - 2 * K + k0) : zero;
            const bf16x8 wg = *(const bf16x8*)(bg + k0), wv = *(const bf16x8*)(bv + k0);
            g0 = __builtin_amdgcn_mfma_f32_16x16x32_bf16(a0, wg, g0, 0, 0, 0);
            g1 = __builtin_amdgcn_mfma_f32_16x16x32_bf16(a1, wg, g1, 0, 0, 0);
            g2 = __builtin_amdgcn_mfma_f32_16x16x32_bf16(a2, wg, g2, 0, 0, 0);
            vv = __builtin_amdgcn_mfma_f32_16x16x32_bf16(a0, wv, vv, 0, 0, 0);
        }
        const float w0 = F.conv_w[gcol], w1 = F.conv_w[DFF + gcol], w2 = F.conv_w[2 * DFF + gcol], cb = F.conv_b[gcol];
#pragma unroll
        for (int e = 0; e < 4; ++e) { const int row = rt * 16 + (F.lane >> 4) * 4 + e;
            const float gate = w0 * g2[e] + w1 * g1[e] + w2 * g0[e] + cb;
            F.ACT[(size_t)row * DFF + gcol] = (bf16)f2bf(gelu_tanh(gate) * vv[e]); }
    }
}

__device__ __forceinline__ float dot64(const v4u (&q)[8], const bf16* krow) {
    float s = 0.f;
#pragma unroll
    for (int i = 0; i < 8; ++i) { const v4u k = *(const v4u*)(krow + 8 * i);
        s += bflo(q[i].x) * bflo(k.x) + bfhi(q[i].x) * bfhi(k.x) + bflo(q[i].y) * bflo(k.y) + bfhi(q[i].y) * bfhi(k.y)
           + bflo(q[i].z) * bflo(k.z) + bfhi(q[i].z) * bfhi(k.z) + bflo(q[i].w) * bflo(k.w) + bfhi(q[i].w) * bfhi(k.w); }
    return s;
}
__device__ __forceinline__ void sattn_phase(Frame& F) {
    const int gw = F.vcu * NWAVES + F.wave, NGW = F.G * NWAVES;
    for (int it = gw; it < M * 4; it += NGW) {
        const int row = it >> 2, hs = it & 3, b = row / SEQ, s = row % SEQ;
        float m = -INFINITY, l = 0.f, acc = 0.f;
#pragma unroll
        for (int g = 0; g < 3; ++g) { const int sh = 2 * g, head = g * 4 + hs;
            const int i = s >> sh, nk = (i < 128 ? i : 128) + 1;
            const size_t qrow = (size_t)(b * NH + head) * SEQ + prow_of(s, sh);
            v4u q[8];
#pragma unroll
            for (int j = 0; j < 8; ++j) q[j] = *(const v4u*)(F.Q + qrow * HD + 8 * j);
            float sc[3];
#pragma unroll
            for (int t = 0; t < 3; ++t) { const int k = F.lane + 64 * t; sc[t] = (k < nk) ? dot64(q, F.K + (qrow - k) * HD) : -INFINITY; }
            const float gm = wave_max(fmaxf(fmaxf(sc[0], sc[1]), sc[2]));
            const float mn = fmaxf(m, gm), alpha = exp2f(m - mn);
            float p[3];
#pragma unroll
            for (int t = 0; t < 3; ++t) p[t] = exp2f(sc[t] - mn);
            l = l * alpha + wave_sum(p[0] + p[1] + p[2]); acc *= alpha; m = mn;
            const bf16* vp = F.V + qrow * HD + F.lane;
#pragma unroll
            for (int t = 0; t < 3; ++t) { const int kend = nk - 64 * t < 64 ? nk - 64 * t : 64;
                for (int kk = 0; kk < kend; ++kk) { const float pk = __shfl(p[t], kk); acc += pk * bf2f(vp[-(long)(64 * t + kk) * HD]); } }
        }
        F.MIX[(size_t)row * NMIX + POOLW + hs * HD + F.lane] = (bf16)f2bf(acc / l);
    }
}
__device__ __forceinline__ void spool_phase(Frame& F) {
    const int gw = F.vcu * NWAVES + F.wave, NGW = F.G * NWAVES;
    for (int row = gw; row < M; row += NGW) { const int s = row % SEQ;
#pragma unroll
        for (int gi = 0; gi < 4; ++gi) { const int w = 2 << gi, cnt = (s + 1 < w) ? s + 1 : w;
            const bf16* up = F.U + (size_t)row * POOLW + gi * 64 + F.lane;
            float sum = 0.f;
            for (int j = 0; j < cnt; ++j) sum += bf2f(up[-(long)j * POOLW]);
            const float mixed = sum / (float)cnt - bf2f(up[0]);
            float y = F.b_pool[gi * 64 + F.lane];
            const float* wp = F.w_pool + (size_t)gi * 64 * 64 + F.lane;
#pragma unroll 8
            for (int c = 0; c < 64; ++c) y += __shfl(mixed, c) * wp[c * 64];
            F.MIX[(size_t)row * NMIX + gi * 64 + F.lane] = (bf16)f2bf(y * F.pool_scale[gi * 64 + F.lane]); }
    }
}

struct Args { const void* in[18]; float* out; unsigned char* ws; int ph_lo, ph_hi, use_bar, pad; };
__global__ void __launch_bounds__(NWAVES * 64, 2) mk_fwd(Args args) {
    extern __shared__ __attribute__((aligned(16))) unsigned char lds[];
    Frame F;
    F.lds = (LAS unsigned char*)lds;
    F.MISC = (volatile LAS unsigned*)(F.lds + MISC_OFF);
    F.tid = threadIdx.x; F.lane = F.tid & 63; F.wave = __builtin_amdgcn_readfirstlane(F.tid >> 6);
    F.G = gridDim.x; { const int bx = blockIdx.x; F.vcu = (F.G % 8 == 0) ? (bx % 8) * (F.G / 8) + bx / 8 : bx; }
    unsigned char* ws = args.ws;
    F.ctl = (gu32*)(ws + WS_CTL);
    F.x = (const float*)args.in[0]; F.c = (const float*)args.in[1]; F.pos = (const int*)args.in[2]; F.w_ada = (const float*)args.in[3]; F.b_ada = (const float*)args.in[4];
    F.g_pre_mix = (const float*)args.in[5]; F.g_post_mix = (const float*)args.in[6]; F.g_pre_ffn = (const float*)args.in[7]; F.g_post_ffn = (const float*)args.in[8];
    F.w_in = (const float*)args.in[9]; F.w_pool = (const float*)args.in[10]; F.b_pool = (const float*)args.in[11]; F.pool_scale = (const float*)args.in[12];
    F.w_out = (const float*)args.in[13]; F.w_up = (const float*)args.in[14]; F.conv_w = (const float*)args.in[15]; F.conv_b = (const float*)args.in[16]; F.w_down = (const float*)args.in[17];
    F.out = args.out;
    F.MOD = (float*)(ws + WS_MOD); F.ROPE = (float*)(ws + WS_ROPE);
    F.WIN = (bf16*)(ws + WS_WIN); F.WOUT = (bf16*)(ws + WS_WOUT); F.WUP = (bf16*)(ws + WS_WUP); F.WDOWN = (bf16*)(ws + WS_WDOWN);
    F.XN = (bf16*)(ws + WS_XN); F.U = (bf16*)(ws + WS_U); F.Q = (bf16*)(ws + WS_Q); F.K = (bf16*)(ws + WS_K); F.V = (bf16*)(ws + WS_V);
    F.MIX = (bf16*)(ws + WS_MIX); F.Y = (bf16*)(ws + WS_Y); F.ACT = (bf16*)(ws + WS_ACT);
    for (int u = F.tid; u < (LDS_BYTES - LDSCTL_OFF) / 4; u += NWAVES * 64) ((LAS unsigned*)(F.lds + LDSCTL_OFF))[u] = 0u;
    __syncthreads();
    XcdBarrier bar; bar.bar = (unsigned*)(F.ctl + CW_BAR); bar.x = 0; bar.st = nullptr;
    if (args.use_bar) bar = xcd_barrier_post((unsigned*)(F.ctl + CW_BAR), F.MISC + 8);
    const int lo = args.ph_lo, hi = args.ph_hi;
#define IN(k) (lo <= (k) && (k) < hi)
#define SEAM(k) do { if (IN(k) && IN((k) + 1)) xcd_barrier(bar); } while (0)

    if (IN(0)) { p0a_phase(F); } SEAM(0);
    if (IN(1)) { p0b_phase(F); } SEAM(1);
    if (IN(2)) { SEpiQKV E{F.U, F.Q, F.K, F.V, F.ROPE}; sgemm_phase(F, F.XN, F.WIN, M, NIN, D, E); } SEAM(2);
    if (IN(3)) { sattn_phase(F); spool_phase(F); } SEAM(3);
    if (IN(4)) { SEpiStore E{F.Y, D}; sgemm_phase(F, F.MIX, F.WOUT, M, D, NMIX, E); } SEAM(4);
    if (IN(5)) { norm1_phase(F); } SEAM(5);
    if (IN(6)) { sgemm_up_phase(F); } SEAM(6);
    if (IN(7)) { SEpiStore E{F.Y, D}; sgemm_phase(F, F.ACT, F.WDOWN, M, D, DFF, E); } SEAM(7);
    if (IN(8)) { norm2_phase(F); }
#undef IN
#undef SEAM
}

extern "C" void kernel_launch(void* const* d_in, const int* in_sizes, int n_in, void* d_out, int out_size, void* d_ws, size_t ws_size, hipStream_t stream) {
    static int grid = 0;
    if (grid == 0) {
        if (n_in != 18 || in_sizes[0] != M * D || out_size != M * D || ws_size < WS_END) {
            fprintf(stderr, "kernel_launch: unexpected shapes: n_in %d in0 %d out %d ws %zu\n", n_in, n_in > 0 ? in_sizes[0] : -1, out_size, ws_size); grid = -1; return; }
        int dev = 0, cus = 0, per_cu = 0;
        if (hipGetDevice(&dev) != hipSuccess || hipDeviceGetAttribute(&cus, hipDeviceAttributeMultiprocessorCount, dev) != hipSuccess) { grid = -1; return; }
        if (hipFuncSetAttribute((const void*)mk_fwd, hipFuncAttributeMaxDynamicSharedMemorySize, LDS_BYTES) != hipSuccess) { fprintf(stderr, "kernel_launch: hipFuncSetAttribute failed\n"); grid = -1; return; }
        if (hipOccupancyMaxActiveBlocksPerMultiprocessor(&per_cu, (const void*)mk_fwd, NWAVES * 64, LDS_BYTES) != hipSuccess || per_cu < 1)
            fprintf(stderr, "kernel_launch: occupancy query reports %d blocks per CU\n", per_cu);
        (void)hipGetLastError();
        grid = cus;
    }
    if (grid < 0) return;
    if (hipMemsetAsync((char*)d_ws + WS_CTL, 0, CTL_ZERO_BYTES, stream) != hipSuccess) return;
    Args a{};
    for (int i = 0; i < 18; ++i) a.in[i] = d_in[i];
    a.out = (float*)d_out; a.ws = (unsigned char*)d_ws;
#if MK_ONE_LAUNCH
    a.ph_lo = 0; a.ph_hi = NPHASE; a.use_bar = 1;
    hipLaunchKernelGGL(mk_fwd, dim3(grid), dim3(NWAVES * 64), LDS_BYTES, stream, a);
#else
    for (int p = 0; p < NPHASE; ++p) { a.ph_lo = p; a.ph_hi = p + 1; a.use_bar = 0;
        hipLaunchKernelGGL(mk_fwd, dim3(grid), dim3(NWAVES * 64), LDS_BYTES, stream, a); }
#endif
}
```

```cpp
#include <hip/hip_runtime.h>
#include <cstdio>
#include <cstdint>

#ifndef MK_ONE_LAUNCH
#define MK_ONE_LAUNCH 1
#endif

constexpr int BATCH = 8, SEQ = 4096, D = 1024, M = BATCH * SEQ;
constexpr int POOLW = 256, AW = 768, NH = 12, HD = 64, NIN = 2560, NMIX = 512, DFF = 2816, NUP = 2 * DFF, NMOD = 6 * D;
constexpr float NORM_EPS = 1e-6f;
constexpr float QSCALE = 0.125f * 1.4426950408889634f;
constexpr int NPHASE = 9;

constexpr size_t MiB = 1u << 20;
constexpr size_t WS_CTL = 0, CTL_ZERO_BYTES = 1 * MiB;
constexpr size_t WS_MOD = 1 * MiB;
constexpr size_t WS_ROPE = 2 * MiB;
constexpr size_t WS_WIN = 4 * MiB, WS_WOUT = 9 * MiB, WS_WUP = 10 * MiB, WS_WDOWN = 21 * MiB;
constexpr size_t WS_XN = 32 * MiB;
constexpr size_t WS_U = 96 * MiB;
constexpr size_t WS_Q = 112 * MiB, WS_K = 160 * MiB, WS_V = 208 * MiB;
constexpr size_t WS_MIX = 256 * MiB;
constexpr size_t WS_Y = 288 * MiB;
constexpr size_t WS_ACT = 96 * MiB;
constexpr size_t WS_END = 352 * MiB;
constexpr int CW_TMO = 0, CW_CODE = 1, CW_BAR = 4096;

constexpr int RING_OFF = 0, RING_BYTES = 131072;
constexpr int LDSCTL_OFF = RING_BYTES, MISC_OFF = LDSCTL_OFF + 320;
constexpr int LDS_BYTES = 147456;
constexpr int NWAVES = 8;

#define GAS __attribute__((address_space(1)))
#define LAS __attribute__((address_space(3)))
typedef unsigned short bf16;
typedef unsigned v4u __attribute__((ext_vector_type(4)));
typedef unsigned v2u __attribute__((ext_vector_type(2)));
typedef float f32x4 __attribute__((ext_vector_type(4)));
typedef short bf16x8 __attribute__((ext_vector_type(8)));
typedef GAS unsigned gu32;
#define RLX_AGENT __ATOMIC_RELAXED, __HIP_MEMORY_SCOPE_AGENT
#define LDS_WAIT() asm volatile("s_waitcnt lgkmcnt(0)" ::: "memory")
#define VM_WAIT() asm volatile("s_waitcnt vmcnt(0)" ::: "memory")

__device__ __forceinline__ unsigned f2bf(float f) { unsigned u = __builtin_bit_cast(unsigned, f); return (u + 0x7fffu + ((u >> 16) & 1u)) >> 16; }
__device__ __forceinline__ unsigned pk2(float lo, float hi) { return f2bf(lo) | (f2bf(hi) << 16); }
__device__ __forceinline__ float bf2f(unsigned short h) { return __builtin_bit_cast(float, (unsigned)h << 16); }
__device__ __forceinline__ float bflo(unsigned w) { return __builtin_bit_cast(float, w << 16); }
__device__ __forceinline__ float bfhi(unsigned w) { return __builtin_bit_cast(float, w & 0xffff0000u); }

#define XB_TMO      128
#define XB_XCNT(j)  (256  + 64 * (j))
#define XB_XSUB(j)  (1280 + 64 * (j))
#define XB_XGEN(j)  (2304 + 64 * (j))
#define XB_TOP      3328
#define XB_TOPGEN   3392
#define XCD_BAR_WORDS 3456
#define XB_SPIN_CAP (1u << 18)
__device__ __forceinline__ unsigned xb_ld(unsigned* p)              { return __hip_atomic_load(p, __ATOMIC_RELAXED, __HIP_MEMORY_SCOPE_AGENT); }
__device__ __forceinline__ unsigned xb_add(unsigned* p, unsigned v) { return __hip_atomic_fetch_add(p, v, __ATOMIC_RELAXED, __HIP_MEMORY_SCOPE_AGENT); }
__device__ __forceinline__ unsigned xb_xcc_id() { return (unsigned)__builtin_amdgcn_s_getreg((3 << 11) | 20) & 0xFu; }
#define XB_SPIN(cond, bar) do { unsigned _sp = 0; while (cond) { __builtin_amdgcn_s_sleep(1); \
    if ((++_sp & 255u) == 0u) { if (xb_ld(&(bar)[XB_TMO])) break; if (_sp > XB_SPIN_CAP) { atomicAdd(&(bar)[XB_TMO], 1u); break; } } } } while (0)
struct XcdBarrier { unsigned* bar; unsigned x; volatile LAS unsigned* st; };
__device__ __forceinline__ XcdBarrier xcd_barrier_post(unsigned* bar, volatile LAS unsigned* st) {
    XcdBarrier b; b.bar = bar; b.x = xb_xcc_id(); b.st = st;
    if (threadIdx.x == 0) (void)xb_add(&bar[XB_XCNT(b.x)], 1u);
    return b;
}
__device__ __forceinline__ void xcd_barrier_complete(unsigned* bar, unsigned x, unsigned& nloc, unsigned& nx) {
    const unsigned G = gridDim.x * gridDim.y * gridDim.z;
    unsigned sum, cnt, mine, sp = 0u;
    for (;;) {
        sum = 0u; cnt = 0u; mine = 0u;
#pragma unroll
        for (unsigned j = 0; j < 16; ++j) { const unsigned c = xb_ld(&bar[XB_XCNT(j)]); sum += c; cnt += (c > 0u) ? 1u : 0u; mine = (j == x) ? c : mine; }
        if (sum == G) break;
        __builtin_amdgcn_s_sleep(1);
        if ((++sp & 255u) == 0u) { if (xb_ld(&bar[XB_TMO])) break; if (sp > XB_SPIN_CAP) { atomicAdd(&bar[XB_TMO], 1u); break; } }
    }
    nloc = mine > 0u ? mine : 1u; nx = cnt > 0u ? cnt : 1u;
}
__device__ __forceinline__ void xcd_barrier(const XcdBarrier& b) {
    asm volatile("s_waitcnt vmcnt(0)" ::: "memory");
    __syncthreads();
    if (threadIdx.x == 0) {
        unsigned* bar = b.bar;
        __builtin_amdgcn_s_waitcnt(0);
        unsigned nloc = b.st[0], nx = b.st[1];
        if (nloc == 0u) { xcd_barrier_complete(bar, b.x, nloc, nx); b.st[0] = nloc; b.st[1] = nx; }
        const unsigned old = xb_add(&bar[XB_XSUB(b.x)], 1u);
        const unsigned gen = old / nloc;
        if (old + 1u == (gen + 1u) * nloc) {
            __builtin_amdgcn_fence(__ATOMIC_RELEASE, "agent");
            asm volatile("s_waitcnt vmcnt(0)" ::: "memory");
            const unsigned og = xb_add(&bar[XB_TOP], 1u);
            const unsigned tg = og / nx;
            if (og + 1u == (tg + 1u) * nx) xb_add(&bar[XB_TOPGEN], 1u);
            else XB_SPIN(xb_ld(&bar[XB_TOPGEN]) == tg, bar);
            __builtin_amdgcn_fence(__ATOMIC_ACQUIRE, "agent");
            xb_add(&bar[XB_XGEN(b.x)], 1u);
            asm volatile("s_waitcnt vmcnt(0)" ::: "memory");
        } else {
            XB_SPIN(xb_ld(&bar[XB_XGEN(b.x)]) == gen, bar);
            __builtin_amdgcn_fence(__ATOMIC_ACQUIRE, "agent");
            asm volatile("s_waitcnt vmcnt(0)" ::: "memory");
        }
    }
    __syncthreads();
}

struct Frame {
    LAS unsigned char* lds;
    volatile LAS unsigned* MISC;
    gu32* ctl;
    int tid, lane, wave;
    int vcu, G;
    const float* x; const float* c; const int* pos; const float* w_ada; const float* b_ada;
    const float *g_pre_mix, *g_post_mix, *g_pre_ffn, *g_post_ffn;
    const float *w_in, *w_pool, *b_pool, *pool_scale, *w_out, *w_up, *conv_w, *conv_b, *w_down;
    float* out;
    float* MOD; float* ROPE;
    bf16 *WIN, *WOUT, *WUP, *WDOWN;
    bf16 *XN, *U, *Q, *K, *V, *MIX, *Y, *ACT;
};

__device__ __forceinline__ float wave_sum(float v) {
#pragma unroll
    for (int o = 1; o < 64; o <<= 1) v += __shfl_xor(v, o);
    return v;
}
__device__ __forceinline__ float wave_max(float v) {
#pragma unroll
    for (int o = 1; o < 64; o <<= 1) v = fmaxf(v, __shfl_xor(v, o));
    return v;
}

template <int MODE> __device__ __forceinline__ int rowmap(int n) {
    if (MODE == 0) return n;
    if (n < DFF) return 256 * (n >> 7) + (n & 127);
    const int m = n - DFF; return 256 * (m >> 7) + 128 + (m & 127);
}
template <int MODE> __device__ __forceinline__ void p0_transpose_item(const float* W, int K, int N, bf16* WT, LAS float* scr, int item, int lane) {
    const int nblk = N / 32, kb = item / nblk, nb = item % nblk, k0 = 64 * kb, n0 = 32 * nb;
#pragma unroll 8
    for (int i = 0; i < 32; ++i) { const int kk = 2 * i + (lane >> 5); scr[kk * 33 + (lane & 31)] = W[(size_t)(k0 + kk) * N + n0 + (lane & 31)]; }
    LDS_WAIT(); asm volatile("" ::: "memory");
    const int c = lane & 7; const int r0 = rowmap<MODE>(n0);
#pragma unroll
    for (int j = 0; j < 4; ++j) { const int n = (lane >> 3) + 8 * j; const LAS float* s = scr + (8 * c) * 33 + n;
        v4u o; o.x = pk2(s[0 * 33], s[1 * 33]); o.y = pk2(s[2 * 33], s[3 * 33]); o.z = pk2(s[4 * 33], s[5 * 33]); o.w = pk2(s[6 * 33], s[7 * 33]);
        *(GAS v4u*)(WT + (size_t)(r0 + n) * K + k0 + 8 * c) = o; }
    LDS_WAIT(); asm volatile("" ::: "memory");
}
__constant__ float INV_FREQ[8] = {1.0f, 0.1939227432012558f, 0.03760603070259094f, 0.007292664609849453f, 0.0014142135623842478f,
                                  0.00027424818836152554f, 5.3182957344688475e-05f, 1.0313385246263351e-05f};
__device__ __forceinline__ void p0a_phase(Frame& F) {
    LAS float* cact = (LAS float*)(F.lds + RING_OFF);
    LAS float* red = (LAS float*)(F.lds + RING_OFF + 32768);
    if (F.vcu < NMOD / 64) {
        for (int i = F.tid; i < BATCH * D; i += NWAVES * 64) { const float v = F.c[i]; cact[i] = v / (1.0f + __expf(-v)); }
        __syncthreads();
        const int n = F.vcu * 64 + F.lane; float acc[BATCH];
#pragma unroll
        for (int b = 0; b < BATCH; ++b) acc[b] = 0.f;
        const int k0 = F.wave * (D / NWAVES);
#pragma unroll 4
        for (int k = k0; k < k0 + D / NWAVES; ++k) { const float w = F.w_ada[(size_t)k * NMOD + n];
#pragma unroll
            for (int b = 0; b < BATCH; ++b) acc[b] += cact[b * D + k] * w; }
#pragma unroll
        for (int b = 0; b < BATCH; ++b) red[(F.wave * BATCH + b) * 64 + F.lane] = acc[b];
        __syncthreads();
        { const int b = F.wave; float s = F.b_ada[n];
#pragma unroll
          for (int w = 0; w < NWAVES; ++w) s += red[(w * BATCH + b) * 64 + F.lane];
          F.MOD[b * NMOD + n] = s; }
        __syncthreads();
    }
    LAS float* scr = (LAS float*)(F.lds + RING_OFF + F.wave * 16384);
    const int gw = F.vcu * NWAVES + F.wave, NGW = F.G * NWAVES;
    constexpr int I_IN = (D / 64) * (NIN / 32), I_OUT = (NMIX / 64) * (D / 32), I_UP = (D / 64) * (NUP / 32), I_DOWN = (DFF / 64) * (D / 32);
    constexpr int NITEMS = I_IN + I_OUT + I_UP + I_DOWN;
    for (int it = NGW - 1 - gw; it < NITEMS; it += NGW) {
        int r = it;
        if (r < I_IN) { p0_transpose_item<0>(F.w_in, D, NIN, F.WIN, scr, r, F.lane); continue; } r -= I_IN;
        if (r < I_OUT) { p0_transpose_item<0>(F.w_out, NMIX, D, F.WOUT, scr, r, F.lane); continue; } r -= I_OUT;
        if (r < I_UP) { p0_transpose_item<1>(F.w_up, D, NUP, F.WUP, scr, r, F.lane); continue; } r -= I_UP;
        p0_transpose_item<0>(F.w_down, DFF, D, F.WDOWN, scr, r, F.lane);
    }
    const int gt = (F.vcu * NWAVES + F.wave) * 64 + F.lane, NGT = NGW * 64;
    for (int idx = gt; idx < M * 8; idx += NGT) { const int row = idx >> 3, j = idx & 7;
        const float ang = (float)F.pos[row] * INV_FREQ[j];
        double rev = (double)ang * 0.15915494309189535; rev -= __builtin_rint(rev);
        const float rf = (float)rev;
        F.ROPE[row * 16 + j] = __builtin_amdgcn_cosf(rf); F.ROPE[row * 16 + 8 + j] = __builtin_amdgcn_sinf(rf); }
}

__device__ __forceinline__ void p0b_phase(Frame& F) {
    const int gw = F.vcu * NWAVES + F.wave, NGW = F.G * NWAVES;
    for (int m = gw; m < M; m += NGW) {
        const int b = m / SEQ; const float* mod = F.MOD + b * NMOD;
        const GAS f32x4* xr = (const GAS f32x4*)(F.x + (size_t)m * D) + F.lane;
        f32x4 v[4]; float s = 0.f;
#pragma unroll
        for (int j = 0; j < 4; ++j) { v[j] = xr[64 * j]; s += (v[j].x * v[j].x + v[j].y * v[j].y) + (v[j].z * v[j].z + v[j].w * v[j].w); }
        const float rstd = 1.0f / sqrtf(wave_sum(s) * (1.f / D) + NORM_EPS);
        GAS v2u* o8 = (GAS v2u*)(F.XN + (size_t)m * D) + F.lane;
#pragma unroll
        for (int j = 0; j < 4; ++j) { const int col = 4 * F.lane + 256 * j;
            const f32x4 g = *(const f32x4*)(F.g_pre_mix + col), sh = *(const f32x4*)(mod + col), sc = *(const f32x4*)(mod + D + col);
            const f32x4 h = v[j] * rstd * g * (sc + 1.0f) + sh;
            v2u w; w.x = pk2(h.x, h.y); w.y = pk2(h.z, h.w); o8[64 * j] = w; }
    }
}
__device__ __forceinline__ void norm1_phase(Frame& F) {
    const int gw = F.vcu * NWAVES + F.wave, NGW = F.G * NWAVES;
    for (int m = gw; m < M; m += NGW) {
        const int b = m / SEQ; const float* mod = F.MOD + b * NMOD;
        const GAS f32x4* xr = (const GAS f32x4*)(F.x + (size_t)m * D) + F.lane;
        const GAS v2u* yr = (const GAS v2u*)(F.Y + (size_t)m * D) + F.lane;
        f32x4 y[4]; float s = 0.f;
#pragma unroll
        for (int j = 0; j < 4; ++j) { const v2u w = yr[64 * j]; y[j] = (f32x4){bflo(w.x), bfhi(w.x), bflo(w.y), bfhi(w.y)};
            s += (y[j].x * y[j].x + y[j].y * y[j].y) + (y[j].z * y[j].z + y[j].w * y[j].w); }
        const float rstd = 1.0f / sqrtf(wave_sum(s) * (1.f / D) + NORM_EPS);
        f32x4 x1[4]; float s2 = 0.f;
        GAS f32x4* orow = (GAS f32x4*)(F.out + (size_t)m * D) + F.lane;
#pragma unroll
        for (int j = 0; j < 4; ++j) { const int col = 4 * F.lane + 256 * j;
            const f32x4 g = *(const f32x4*)(F.g_post_mix + col), gt = *(const f32x4*)(mod + 2 * D + col);
            x1[j] = xr[64 * j] + gt * (y[j] * rstd * g); orow[64 * j] = x1[j];
            s2 += (x1[j].x * x1[j].x + x1[j].y * x1[j].y) + (x1[j].z * x1[j].z + x1[j].w * x1[j].w); }
        const float rstd2 = 1.0f / sqrtf(wave_sum(s2) * (1.f / D) + NORM_EPS);
        GAS v2u* o8 = (GAS v2u*)(F.XN + (size_t)m * D) + F.lane;
#pragma unroll
        for (int j = 0; j < 4; ++j) { const int col = 4 * F.lane + 256 * j;
            const f32x4 g = *(const f32x4*)(F.g_pre_ffn + col), sh = *(const f32x4*)(mod + 3 * D + col), sc = *(const f32x4*)(mod + 4 * D + col);
            const f32x4 h = x1[j] * rstd2 * g * (sc + 1.0f) + sh;
            v2u w; w.x = pk2(h.x, h.y); w.y = pk2(h.z, h.w); o8[64 * j] = w; }
    }
}
__device__ __forceinline__ void norm2_phase(Frame& F) {
    const int gw = F.vcu * NWAVES + F.wave, NGW = F.G * NWAVES;
    for (int m = gw; m < M; m += NGW) {
        const int b = m / SEQ; const float* mod = F.MOD + b * NMOD;
        const GAS v2u* yr = (const GAS v2u*)(F.Y + (size_t)m * D) + F.lane;
        f32x4 y[4]; float s = 0.f;
#pragma unroll
        for (int j = 0; j < 4; ++j) { const v2u w = yr[64 * j]; y[j] = (f32x4){bflo(w.x), bfhi(w.x), bflo(w.y), bfhi(w.y)};
            s += (y[j].x * y[j].x + y[j].y * y[j].y) + (y[j].z * y[j].z + y[j].w * y[j].w); }
        const float rstd = 1.0f / sqrtf(wave_sum(s) * (1.f / D) + NORM_EPS);
        GAS f32x4* orow = (GAS f32x4*)(F.out + (size_t)m * D) + F.lane;
#pragma unroll
        for (int j = 0; j < 4; ++j) { const int col = 4 * F.lane + 256 * j;
            const f32x4 g = *(const f32x4*)(F.g_post_ffn + col), gt = *(const f32x4*)(mod + 5 * D + col);
            orow[64 * j] = orow[64 * j] + gt * (y[j] * rstd * g); }
    }
}

template <class Epi> __device__ __forceinline__ void sgemm_phase(Frame& F, const bf16* A, const bf16* Bt, int Mr, int N, int K, const Epi& E) {
    const int gw = F.vcu * NWAVES + F.wave, NGW = F.G * NWAVES;
    const int ntn = N / 64, nit = (Mr / 16) * ntn;
    const int lr = F.lane & 15, kq = (F.lane >> 4) * 8;
    for (int it = gw; it < nit; it += NGW) {
        const int rt = it / ntn, ct = it % ntn;
        const bf16* ap = A + (size_t)(rt * 16 + lr) * K + kq;
        const bf16* bp = Bt + (size_t)(ct * 64 + lr) * K + kq;
        f32x4 acc[4];
#pragma unroll
        for (int j = 0; j < 4; ++j) acc[j] = (f32x4){0.f, 0.f, 0.f, 0.f};
#pragma unroll 4
        for (int k0 = 0; k0 < K; k0 += 32) {
            const bf16x8 a = *(const bf16x8*)(ap + k0);
#pragma unroll
            for (int j = 0; j < 4; ++j) { const bf16x8 bv = *(const bf16x8*)(bp + (size_t)(16 * j) * K + k0);
                acc[j] = __builtin_amdgcn_mfma_f32_16x16x32_bf16(a, bv, acc[j], 0, 0, 0); }
        }
        E(acc, rt, ct, F.lane);
    }
}
struct SEpiStore { bf16* O; int ldc;
    __device__ __forceinline__ void operator()(const f32x4 (&acc)[4], int rt, int ct, int lane) const {
#pragma unroll
        for (int e = 0; e < 4; ++e) { const int row = rt * 16 + (lane >> 4) * 4 + e;
#pragma unroll
            for (int j = 0; j < 4; ++j) O[(size_t)row * ldc + ct * 64 + 16 * j + (lane & 15)] = (bf16)f2bf(acc[j][e]); }
    }
};
__device__ __forceinline__ int prow_of(int s, int sh) { return ((s & ((1 << sh) - 1)) << (12 - sh)) + (s >> sh); }
struct SEpiQKV { bf16 *U, *Q, *K, *V; const float* rope;
    __device__ __forceinline__ void operator()(const f32x4 (&acc)[4], int rt, int ct, int lane) const {
        const int col0 = ct * 64;
        if (col0 < POOLW) {
#pragma unroll
            for (int e = 0; e < 4; ++e) { const int row = rt * 16 + (lane >> 4) * 4 + e;
#pragma unroll
                for (int j = 0; j < 4; ++j) U[(size_t)row * POOLW + col0 + 16 * j + (lane & 15)] = (bf16)f2bf(acc[j][e]); }
            return;
        }
        const int c = col0 - POOLW, part = c / AW, hh = (c % AW) / HD, sh = 2 * (hh >> 2);
        bf16* dst = Q + (size_t)part * ((WS_K - WS_Q) / 2);
#pragma unroll
        for (int e = 0; e < 4; ++e) { const int row = rt * 16 + (lane >> 4) * 4 + e, b = row / SEQ, s = row % SEQ;
            const size_t base = ((size_t)(b * NH + hh) * SEQ + prow_of(s, sh)) * HD;
#pragma unroll
            for (int j = 0; j < 4; ++j) { const int dd = 16 * j + (lane & 15); float v = acc[j][e];
                if (j == 0 && part < 2) { const float partner = __shfl_xor(v, 8); const int jj = dd & 7;
                    const float cs = rope[row * 16 + jj], sn = rope[row * 16 + 8 + jj];
                    v = (dd < 8) ? (v * cs - partner * sn) : (v * cs + partner * sn); }
                if (part == 0) v *= QSCALE;
                dst[base + dd] = (bf16)f2bf(v); } }
    }
};
__device__ __forceinline__ float gelu_tanh(float x) {
    const float u = 0.7978845608028654f * (x + 0.044715f * x * x * x);
    const float t = 1.0f - 2.0f / (__expf(2.0f * u) + 1.0f);
    return 0.5f * x * (1.0f + t);
}
__device__ __forceinline__ void sgemm_up_phase(Frame& F) {
    const int gw = F.vcu * NWAVES + F.wave, NGW = F.G * NWAVES;
    constexpr int ntn = DFF / 16, nit = (M / 16) * ntn, K = D;
    const int lr = F.lane & 15, kq = (F.lane >> 4) * 8;
    for (int it = gw; it < nit; it += NGW) {
        const int rt = it / ntn, ct = it % ntn;
        const int arow = rt * 16 + lr, as = arow % SEQ;
        const bf16* ap = F.XN + (size_t)arow * K + kq;
        const int gcol = ct * 16 + lr;
        const bf16* bg = F.WUP + (size_t)(256 * (gcol >> 7) + (gcol & 127)) * K + kq;
        const bf16* bv = bg + (size_t)128 * K;
        f32x4 g0 = {0.f, 0.f, 0.f, 0.f}, g1 = g0, g2 = g0, vv = g0;
        const bf16x8 zero = {0, 0, 0, 0, 0, 0, 0, 0};
#pragma unroll 2
        for (int k0 = 0; k0 < K; k0 += 32) {
            const bf16x8 a0 = *(const bf16x8*)(ap + k0);
            const bf16x8 a1 = as >= 1 ? *(const bf16x8*)(ap - K + k0) : zero;
            const bf16x8 a2 = as >= 2 ? *(const bf16x8*)(ap - 2 * K + k0) : zero;
            const bf16x8 wg = *(const bf16x8*)(bg + k0), wv = *(const bf16x8*)(bv + k0);
            g0 = __builtin_amdgcn_mfma_f32_16x16x32_bf16(a0, wg, g0, 0, 0, 0);
            g1 = __builtin_amdgcn_mfma_f32_16x16x32_bf16(a1, wg, g1, 0, 0, 0);
            g2 = __builtin_amdgcn_mfma_f32_16x16x32_bf16(a2, wg, g2, 0, 0, 0);
            vv = __builtin_amdgcn_mfma_f32_16x16x32_bf16(a0, wv, vv, 0, 0, 0);
        }
        const float w0 = F.conv_w[gcol], w1 = F.conv_w[DFF + gcol], w2 = F.conv_w[2 * DFF + gcol], cb = F.conv_b[gcol];
#pragma unroll
        for (int e = 0; e < 4; ++e) { const int row = rt * 16 + (F.lane >> 4) * 4 + e;
            const float gate = w0 * g2[e] + w1 * g1[e] + w2 * g0[e] + cb;
            F.ACT[(size_t)row * DFF + gcol] = (bf16)f2bf(gelu_tanh(gate) * vv[e]); }
    }
}

__device__ __forceinline__ float dot64(const v4u (&q)[8], const bf16* krow) {
    float s = 0.f;
#pragma unroll
    for (int i = 0; i < 8; ++i) { const v4u k = *(const v4u*)(krow + 8 * i);
        s += bflo(q[i].x) * bflo(k.x) + bfhi(q[i].x) * bfhi(k.x) + bflo(q[i].y) * bflo(k.y) + bfhi(q[i].y) * bfhi(k.y)
           + bflo(q[i].z) * bflo(k.z) + bfhi(q[i].z) * bfhi(k.z) + bflo(q[i].w) * bflo(k.w) + bfhi(q[i].w) * bfhi(k.w); }
    return s;
}
__device__ __forceinline__ void sattn_phase(Frame& F) {
    const int gw = F.vcu * NWAVES + F.wave, NGW = F.G * NWAVES;
    for (int it = gw; it < M * 4; it += NGW) {
        const int row = it >> 2, hs = it & 3, b = row / SEQ, s = row % SEQ;
        float m = -INFINITY, l = 0.f, acc = 0.f;
#pragma unroll
        for (int g = 0; g < 3; ++g) { const int sh = 2 * g, head = g * 4 + hs;
            const int i = s >> sh, nk = (i < 128 ? i : 128) + 1;
            const size_t qrow = (size_t)(b * NH + head) * SEQ + prow_of(s, sh);
            v4u q[8];
#pragma unroll
            for (int j = 0; j < 8; ++j) q[j] = *(const v4u*)(F.Q + qrow * HD + 8 * j);
            float sc[3];
#pragma unroll
            for (int t = 0; t < 3; ++t) { const int k = F.lane + 64 * t; sc[t] = (k < nk) ? dot64(q, F.K + (qrow - k) * HD) : -INFINITY; }
            const float gm = wave_max(fmaxf(fmaxf(sc[0], sc[1]), sc[2]));
            const float mn = fmaxf(m, gm), alpha = exp2f(m - mn);
            float p[3];
#pragma unroll
            for (int t = 0; t < 3; ++t) p[t] = exp2f(sc[t] - mn);
            l = l * alpha + wave_sum(p[0] + p[1] + p[2]); acc *= alpha; m = mn;
            const bf16* vp = F.V + qrow * HD + F.lane;
#pragma unroll
            for (int t = 0; t < 3; ++t) { const int kend = nk - 64 * t < 64 ? nk - 64 * t : 64;
                for (int kk = 0; kk < kend; ++kk) { const float pk = __shfl(p[t], kk); acc += pk * bf2f(vp[-(long)(64 * t + kk) * HD]); } }
        }
        F.MIX[(size_t)row * NMIX + POOLW + hs * HD + F.lane] = (bf16)f2bf(acc / l);
    }
}
__device__ __forceinline__ void spool_phase(Frame& F) {
    const int gw = F.vcu * NWAVES + F.wave, NGW = F.G * NWAVES;
    for (int row = gw; row < M; row += NGW) { const int s = row % SEQ;
#pragma unroll
        for (int gi = 0; gi < 4; ++gi) { const int w = 2 << gi, cnt = (s + 1 < w) ? s + 1 : w;
            const bf16* up = F.U + (size_t)row * POOLW + gi * 64 + F.lane;
            float sum = 0.f;
            for (int j = 0; j < cnt; ++j) sum += bf2f(up[-(long)j * POOLW]);
            const float mixed = sum / (float)cnt - bf2f(up[0]);
            float y = F.b_pool[gi * 64 + F.lane];
            const float* wp = F.w_pool + (size_t)gi * 64 * 64 + F.lane;
#pragma unroll 8
            for (int c = 0; c < 64; ++c) y += __shfl(mixed, c) * wp[c * 64];
            F.MIX[(size_t)row * NMIX + gi * 64 + F.lane] = (bf16)f2bf(y * F.pool_scale[gi * 64 + F.lane]); }
    }
}

struct Args { const void* in[18]; float* out; unsigned char* ws; int ph_lo, ph_hi, use_bar, pad; };
__global__ void __launch_bounds__(NWAVES * 64, 2) mk_fwd(Args args) {
    extern __shared__ __attribute__((aligned(16))) unsigned char lds[];
    Frame F;
    F.lds = (LAS unsigned char*)lds;
    F.MISC = (volatile LAS unsigned*)(F.lds + MISC_OFF);
    F.tid = threadIdx.x; F.lane = F.tid & 63; F.wave = __builtin_amdgcn_readfirstlane(F.tid >> 6);
    F.G = gridDim.x; { const int bx = blockIdx.x; F.vcu = (F.G % 8 == 0) ? (bx % 8) * (F.G / 8) + bx / 8 : bx; }
    unsigned char* ws = args.ws;
    F.ctl = (gu32*)(ws + WS_CTL);
    F.x = (const float*)args.in[0]; F.c = (const float*)args.in[1]; F.pos = (const int*)args.in[2]; F.w_ada = (const float*)args.in[3]; F.b_ada = (const float*)args.in[4];
    F.g_pre_mix = (const float*)args.in[5]; F.g_post_mix = (const float*)args.in[6]; F.g_pre_ffn = (const float*)args.in[7]; F.g_post_ffn = (const float*)args.in[8];
    F.w_in = (const float*)args.in[9]; F.w_pool = (const float*)args.in[10]; F.b_pool = (const float*)args.in[11]; F.pool_scale = (const float*)args.in[12];
    F.w_out = (const float*)args.in[13]; F.w_up = (const float*)args.in[14]; F.conv_w = (const float*)args.in[15]; F.conv_b = (const float*)args.in[16]; F.w_down = (const float*)args.in[17];
    F.out = args.out;
    F.MOD = (float*)(ws + WS_MOD); F.ROPE = (float*)(ws + WS_ROPE);
    F.WIN = (bf16*)(ws + WS_WIN); F.WOUT = (bf16*)(ws + WS_WOUT); F.WUP = (bf16*)(ws + WS_WUP); F.WDOWN = (bf16*)(ws + WS_WDOWN);
    F.XN = (bf16*)(ws + WS_XN); F.U = (bf16*)(ws + WS_U); F.Q = (bf16*)(ws + WS_Q); F.K = (bf16*)(ws + WS_K); F.V = (bf16*)(ws + WS_V);
    F.MIX = (bf16*)(ws + WS_MIX); F.Y = (bf16*)(ws + WS_Y); F.ACT = (bf16*)(ws + WS_ACT);
    for (int u = F.tid; u < (LDS_BYTES - LDSCTL_OFF) / 4; u += NWAVES * 64) ((LAS unsigned*)(F.lds + LDSCTL_OFF))[u] = 0u;
    __syncthreads();
    XcdBarrier bar; bar.bar = (unsigned*)(F.ctl + CW_BAR); bar.x = 0; bar.st = nullptr;
    if (args.use_bar) bar = xcd_barrier_post((unsigned*)(F.ctl + CW_BAR), F.MISC + 8);
    const int lo = args.ph_lo, hi = args.ph_hi;
#define IN(k) (lo <= (k) && (k) < hi)
#define SEAM(k) do { if (IN(k) && IN((k) + 1)) xcd_barrier(bar); } while (0)

    if (IN(0)) { p0a_phase(F); } SEAM(0);
    if (IN(1)) { p0b_phase(F); } SEAM(1);
    if (IN(2)) { SEpiQKV E{F.U, F.Q, F.K, F.V, F.ROPE}; sgemm_phase(F, F.XN, F.WIN, M, NIN, D, E); } SEAM(2);
    if (IN(3)) { sattn_phase(F); spool_phase(F); } SEAM(3);
    if (IN(4)) { SEpiStore E{F.Y, D}; sgemm_phase(F, F.MIX, F.WOUT, M, D, NMIX, E); } SEAM(4);
    if (IN(5)) { norm1_phase(F); } SEAM(5);
    if (IN(6)) { sgemm_up_phase(F); } SEAM(6);
    if (IN(7)) { SEpiStore E{F.Y, D}; sgemm_phase(F, F.ACT, F.WDOWN, M, D, DFF, E); } SEAM(7);
    if (IN(8)) { norm2_phase(F); }
#undef IN
#undef SEAM
}

extern "C" void kernel_launch(void* const* d_in, const int* in_sizes, int n_in, void* d_out, int out_size, void* d_ws, size_t ws_size, hipStream_t stream) {
    static int grid = 0;
    if (grid == 0) {
        if (n_in != 18 || in_sizes[0] != M * D || out_size != M * D || ws_size < WS_END) {
            fprintf(stderr, "kernel_launch: unexpected shapes: n_in %d in0 %d out %d ws %zu\n", n_in, n_in > 0 ? in_sizes[0] : -1, out_size, ws_size); grid = -1; return; }
        int dev = 0, cus = 0, per_cu = 0;
        if (hipGetDevice(&dev) != hipSuccess || hipDeviceGetAttribute(&cus, hipDeviceAttributeMultiprocessorCount, dev) != hipSuccess) { grid = -1; return; }
        if (hipFuncSetAttribute((const void*)mk_fwd, hipFuncAttributeMaxDynamicSharedMemorySize, LDS_BYTES) != hipSuccess) { fprintf(stderr, "kernel_launch: hipFuncSetAttribute failed\n"); grid = -1; return; }
        if (hipOccupancyMaxActiveBlocksPerMultiprocessor(&per_cu, (const void*)mk_fwd, NWAVES * 64, LDS_BYTES) != hipSuccess || per_cu < 1)
            fprintf(stderr, "kernel_launch: occupancy query reports %d blocks per CU\n", per_cu);
        (void)hipGetLastError();
        grid = cus;
    }
    if (grid < 0) return;
    if (hipMemsetAsync((char*)d_ws + WS_CTL, 0, CTL_ZERO_BYTES, stream) != hipSuccess) return;
    Args a{};
    for (int i = 0; i < 18; ++i) a.in[i] = d_in[i];
    a.out = (float*)d_out; a.ws = (unsigned char*)d_ws;
#if MK_ONE_LAUNCH
    a.ph_lo = 0; a.ph_hi = NPHASE; a.use_bar = 1;
    hipLaunchKernelGGL(mk_fwd, dim3(grid), dim3(NWAVES * 64), LDS_BYTES, stream, a);
#else
    for (int p = 0; p < NPHASE; ++p) { a.ph_lo = p; a.ph_hi = p + 1; a.use_bar = 0;
        hipLaunchKernelGGL(mk_fwd, dim3(grid), dim3(NWAVES * 64), LDS_BYTES, stream, a); }
#endif
}
```

```cpp
#include <hip/hip_runtime.h>
#include <cstdio>
#include <cstdint>

#ifndef MK_ONE_LAUNCH
#define MK_ONE_LAUNCH 1
#endif

constexpr int BATCH = 8, SEQ = 4096, D = 1024, M = BATCH * SEQ;
constexpr int POOLW = 256, AW = 768, NH = 12, HD = 64, NIN = 2560, NMIX = 512, DFF = 2816, NUP = 2 * DFF, NMOD = 6 * D;
constexpr float NORM_EPS = 1e-6f;
constexpr float QSCALE = 0.125f * 1.4426950408889634f;
constexpr int NPHASE = 9;

constexpr size_t MiB = 1u << 20;
constexpr size_t WS_CTL = 0, CTL_ZERO_BYTES = 1 * MiB;
constexpr size_t WS_MOD = 1 * MiB;
constexpr size_t WS_ROPE = 2 * MiB;
constexpr size_t WS_WIN = 4 * MiB, WS_WOUT = 9 * MiB, WS_WUP = 10 * MiB, WS_WDOWN = 21 * MiB;
constexpr size_t WS_XN = 32 * MiB;
constexpr size_t WS_U = 96 * MiB;
constexpr size_t WS_Q = 112 * MiB, WS_K = 160 * MiB, WS_V = 208 * MiB;
constexpr size_t WS_MIX = 256 * MiB;
constexpr size_t WS_Y = 288 * MiB;
constexpr size_t WS_ACT = 96 * MiB;
constexpr size_t WS_TAIL = 352 * MiB, WS_HEAD = 356 * MiB;
constexpr size_t WS_SCRO = 362 * MiB, WS_SCRML = 394 * MiB;
constexpr size_t WS_WPT = 27 * MiB;
constexpr size_t WS_END = 395 * MiB;
constexpr int CW_TMO = 0, CW_CODE = 1, CW_BAR = 4096;

constexpr int RING_OFF = 0, RING_BYTES = 131072;
constexpr int LDSCTL_OFF = RING_BYTES, MISC_OFF = LDSCTL_OFF + 320;
constexpr int XB_OFF = LDSCTL_OFF + 512;
constexpr int LDS_BYTES = 147456;
constexpr int NWAVES = 8;

#define GAS __attribute__((address_space(1)))
#define LAS __attribute__((address_space(3)))
typedef unsigned short bf16;
typedef unsigned v4u __attribute__((ext_vector_type(4)));
typedef unsigned v2u __attribute__((ext_vector_type(2)));
typedef float f32x4 __attribute__((ext_vector_type(4)));
typedef short bf16x8 __attribute__((ext_vector_type(8)));
typedef GAS unsigned gu32;
#define RLX_AGENT __ATOMIC_RELAXED, __HIP_MEMORY_SCOPE_AGENT
#define LDS_WAIT() asm volatile("s_waitcnt lgkmcnt(0)" ::: "memory")
#define VM_WAIT() asm volatile("s_waitcnt vmcnt(0)" ::: "memory")

__device__ __forceinline__ unsigned f2bf(float f) { unsigned u = __builtin_bit_cast(unsigned, f); return (u + 0x7fffu + ((u >> 16) & 1u)) >> 16; }
__device__ __forceinline__ unsigned pk2(float lo, float hi) { return f2bf(lo) | (f2bf(hi) << 16); }
__device__ __forceinline__ float bf2f(unsigned short h) { return __builtin_bit_cast(float, (unsigned)h << 16); }
__device__ __forceinline__ float bflo(unsigned w) { return __builtin_bit_cast(float, w << 16); }
__device__ __forceinline__ float bfhi(unsigned w) { return __builtin_bit_cast(float, w & 0xffff0000u); }

#define XB_TMO      128
#define XB_XCNT(j)  (256  + 64 * (j))
#define XB_XSUB(j)  (1280 + 64 * (j))
#define XB_XGEN(j)  (2304 + 64 * (j))
#define XB_TOP      3328
#define XB_TOPGEN   3392
#define XCD_BAR_WORDS 3456
#define XB_SPIN_CAP (1u << 18)
__device__ __forceinline__ unsigned xb_ld(unsigned* p)              { return __hip_atomic_load(p, __ATOMIC_RELAXED, __HIP_MEMORY_SCOPE_AGENT); }
__device__ __forceinline__ unsigned xb_add(unsigned* p, unsigned v) { return __hip_atomic_fetch_add(p, v, __ATOMIC_RELAXED, __HIP_MEMORY_SCOPE_AGENT); }
__device__ __forceinline__ unsigned xb_xcc_id() { return (unsigned)__builtin_amdgcn_s_getreg((3 << 11) | 20) & 0xFu; }
#define XB_SPIN(cond, bar) do { unsigned _sp = 0; while (cond) { __builtin_amdgcn_s_sleep(1); \
    if ((++_sp & 255u) == 0u) { if (xb_ld(&(bar)[XB_TMO])) break; if (_sp > XB_SPIN_CAP) { atomicAdd(&(bar)[XB_TMO], 1u); break; } } } } while (0)
struct XcdBarrier { unsigned* bar; unsigned x; volatile LAS unsigned* st; };
__device__ __forceinline__ XcdBarrier xcd_barrier_post(unsigned* bar, volatile LAS unsigned* st) {
    XcdBarrier b; b.bar = bar; b.x = xb_xcc_id(); b.st = st;
    if (threadIdx.x == 0) (void)xb_add(&bar[XB_XCNT(b.x)], 1u);
    return b;
}
__device__ __forceinline__ void xcd_barrier_complete(unsigned* bar, unsigned x, unsigned& nloc, unsigned& nx) {
    const unsigned G = gridDim.x * gridDim.y * gridDim.z;
    unsigned sum, cnt, mine, sp = 0u;
    for (;;) {
        sum = 0u; cnt = 0u; mine = 0u;
#pragma unroll
        for (unsigned j = 0; j < 16; ++j) { const unsigned c = xb_ld(&bar[XB_XCNT(j)]); sum += c; cnt += (c > 0u) ? 1u : 0u; mine = (j == x) ? c : mine; }
        if (sum == G) break;
        __builtin_amdgcn_s_sleep(1);
        if ((++sp & 255u) == 0u) { if (xb_ld(&bar[XB_TMO])) break; if (sp > XB_SPIN_CAP) { atomicAdd(&bar[XB_TMO], 1u); break; } }
    }
    nloc = mine > 0u ? mine : 1u; nx = cnt > 0u ? cnt : 1u;
}
__device__ __forceinline__ void xcd_barrier(const XcdBarrier& b) {
    asm volatile("s_waitcnt vmcnt(0)" ::: "memory");
    __syncthreads();
    if (threadIdx.x == 0) {
        unsigned* bar = b.bar;
        __builtin_amdgcn_s_waitcnt(0);
        unsigned nloc = b.st[0], nx = b.st[1];
        if (nloc == 0u) { xcd_barrier_complete(bar, b.x, nloc, nx); b.st[0] = nloc; b.st[1] = nx; }
        const unsigned old = xb_add(&bar[XB_XSUB(b.x)], 1u);
        const unsigned gen = old / nloc;
        if (old + 1u == (gen + 1u) * nloc) {
            __builtin_amdgcn_fence(__ATOMIC_RELEASE, "agent");
            asm volatile("s_waitcnt vmcnt(0)" ::: "memory");
            const unsigned og = xb_add(&bar[XB_TOP], 1u);
            const unsigned tg = og / nx;
            if (og + 1u == (tg + 1u) * nx) xb_add(&bar[XB_TOPGEN], 1u);
            else XB_SPIN(xb_ld(&bar[XB_TOPGEN]) == tg, bar);
            __builtin_amdgcn_fence(__ATOMIC_ACQUIRE, "agent");
            xb_add(&bar[XB_XGEN(b.x)], 1u);
            asm volatile("s_waitcnt vmcnt(0)" ::: "memory");
        } else {
            XB_SPIN(xb_ld(&bar[XB_XGEN(b.x)]) == gen, bar);
            __builtin_amdgcn_fence(__ATOMIC_ACQUIRE, "agent");
            asm volatile("s_waitcnt vmcnt(0)" ::: "memory");
        }
    }
    __syncthreads();
}

struct Frame {
    LAS unsigned char* lds;
    volatile LAS unsigned* MISC;
    gu32* ctl;
    int tid, lane, wave;
    int vcu, G;
    const float* x; const float* c; const int* pos; const float* w_ada; const float* b_ada;
    const float *g_pre_mix, *g_post_mix, *g_pre_ffn, *g_post_ffn;
    const float *w_in, *w_pool, *b_pool, *pool_scale, *w_out, *w_up, *conv_w, *conv_b, *w_down;
    float* out;
    float* MOD; float* ROPE;
    bf16 *WIN, *WOUT, *WUP, *WDOWN;
    bf16 *XN, *U, *Q, *K, *V, *MIX, *Y, *ACT;
    float *TAIL, *HEAD, *SCRO, *SCRML; bf16* WPT;
};

__device__ __forceinline__ float wave_sum(float v) {
#pragma unroll
    for (int o = 1; o < 64; o <<= 1) v += __shfl_xor(v, o);
    return v;
}
__device__ __forceinline__ float wave_max(float v) {
#pragma unroll
    for (int o = 1; o < 64; o <<= 1) v = fmaxf(v, __shfl_xor(v, o));
    return v;
}

template <int MODE> __device__ __forceinline__ int rowmap(int n) {
    if (MODE == 0) return n;
    if (n < DFF) return 256 * (n >> 7) + (n & 127);
    const int m = n - DFF; return 256 * (m >> 7) + 128 + (m & 127);
}
template <int MODE> __device__ __forceinline__ void p0_transpose_item(const float* W, int K, int N, bf16* WT, LAS float* scr, int item, int lane) {
    const int nblk = N / 32, kb = item / nblk, nb = item % nblk, k0 = 64 * kb, n0 = 32 * nb;
#pragma unroll 8
    for (int i = 0; i < 32; ++i) { const int kk = 2 * i + (lane >> 5); scr[kk * 33 + (lane & 31)] = W[(size_t)(k0 + kk) * N + n0 + (lane & 31)]; }
    LDS_WAIT(); asm volatile("" ::: "memory");
    const int c = lane & 7; const int r0 = rowmap<MODE>(n0);
#pragma unroll
    for (int j = 0; j < 4; ++j) { const int n = (lane >> 3) + 8 * j; const LAS float* s = scr + (8 * c) * 33 + n;
        v4u o; o.x = pk2(s[0 * 33], s[1 * 33]); o.y = pk2(s[2 * 33], s[3 * 33]); o.z = pk2(s[4 * 33], s[5 * 33]); o.w = pk2(s[6 * 33], s[7 * 33]);
        *(GAS v4u*)(WT + (size_t)(r0 + n) * K + k0 + 8 * c) = o; }
    LDS_WAIT(); asm volatile("" ::: "memory");
}
__constant__ float INV_FREQ[8] = {1.0f, 0.1939227432012558f, 0.03760603070259094f, 0.007292664609849453f, 0.0014142135623842478f,
                                  0.00027424818836152554f, 5.3182957344688475e-05f, 1.0313385246263351e-05f};
__device__ __forceinline__ void p0a_phase(Frame& F) {
    LAS float* cact = (LAS float*)(F.lds + RING_OFF);
    LAS float* red = (LAS float*)(F.lds + RING_OFF + 32768);
    if (F.vcu < NMOD / 64) {
        for (int i = F.tid; i < BATCH * D; i += NWAVES * 64) { const float v = F.c[i]; cact[i] = v / (1.0f + __expf(-v)); }
        __syncthreads();
        const int n = F.vcu * 64 + F.lane; float acc[BATCH];
#pragma unroll
        for (int b = 0; b < BATCH; ++b) acc[b] = 0.f;
        const int k0 = F.wave * (D / NWAVES);
#pragma unroll 4
        for (int k = k0; k < k0 + D / NWAVES; ++k) { const float w = F.w_ada[(size_t)k * NMOD + n];
#pragma unroll
            for (int b = 0; b < BATCH; ++b) acc[b] += cact[b * D + k] * w; }
#pragma unroll
        for (int b = 0; b < BATCH; ++b) red[(F.wave * BATCH + b) * 64 + F.lane] = acc[b];
        __syncthreads();
        { const int b = F.wave; float s = F.b_ada[n];
#pragma unroll
          for (int w = 0; w < NWAVES; ++w) s += red[(w * BATCH + b) * 64 + F.lane];
          F.MOD[b * NMOD + n] = s; }
        __syncthreads();
    }
    LAS float* scr = (LAS float*)(F.lds + RING_OFF + F.wave * 16384);
    const int gw = F.vcu * NWAVES + F.wave, NGW = F.G * NWAVES;
    constexpr int I_IN = (D / 64) * (NIN / 32), I_OUT = (NMIX / 64) * (D / 32), I_UP = (D / 64) * (NUP / 32), I_DOWN = (DFF / 64) * (D / 32);
    constexpr int NITEMS = I_IN + I_OUT + I_UP + I_DOWN;
    for (int it = NGW - 1 - gw; it < NITEMS; it += NGW) {
        int r = it;
        if (r < I_IN) { p0_transpose_item<0>(F.w_in, D, NIN, F.WIN, scr, r, F.lane); continue; } r -= I_IN;
        if (r < I_OUT) { p0_transpose_item<0>(F.w_out, NMIX, D, F.WOUT, scr, r, F.lane); continue; } r -= I_OUT;
        if (r < I_UP) { p0_transpose_item<1>(F.w_up, D, NUP, F.WUP, scr, r, F.lane); continue; } r -= I_UP;
        p0_transpose_item<0>(F.w_down, DFF, D, F.WDOWN, scr, r, F.lane);
    }
    const int gt = (F.vcu * NWAVES + F.wave) * 64 + F.lane, NGT = NGW * 64;
    for (int idx = gt; idx < M * 8; idx += NGT) { const int row = idx >> 3, j = idx & 7;
        const float ang = (float)F.pos[row] * INV_FREQ[j];
        double rev = (double)ang * 0.15915494309189535; rev -= __builtin_rint(rev);
        const float rf = (float)rev;
        F.ROPE[row * 16 + j] = __builtin_amdgcn_cosf(rf); F.ROPE[row * 16 + 8 + j] = __builtin_amdgcn_sinf(rf); }
    for (int idx = gt; idx < 4 * 64 * 64; idx += NGT) { const int gi = idx >> 12, d = (idx >> 6) & 63, c = idx & 63; F.WPT[idx] = (bf16)f2bf(F.w_pool[(gi * 64 + c) * 64 + d]); }
}

__device__ __forceinline__ void p0b_phase(Frame& F) {
    const int gw = F.vcu * NWAVES + F.wave, NGW = F.G * NWAVES;
    for (int m = gw; m < M; m += NGW) {
        const int b = m / SEQ; const float* mod = F.MOD + b * NMOD;
        const GAS f32x4* xr = (const GAS f32x4*)(F.x + (size_t)m * D) + F.lane;
        f32x4 v[4]; float s = 0.f;
#pragma unroll
        for (int j = 0; j < 4; ++j) { v[j] = xr[64 * j]; s += (v[j].x * v[j].x + v[j].y * v[j].y) + (v[j].z * v[j].z + v[j].w * v[j].w); }
        const float rstd = 1.0f / sqrtf(wave_sum(s) * (1.f / D) + NORM_EPS);
        GAS v2u* o8 = (GAS v2u*)(F.XN + (size_t)m * D) + F.lane;
#pragma unroll
        for (int j = 0; j < 4; ++j) { const int col = 4 * F.lane + 256 * j;
            const f32x4 g = *(const f32x4*)(F.g_pre_mix + col), sh = *(const f32x4*)(mod + col), sc = *(const f32x4*)(mod + D + col);
            const f32x4 h = v[j] * rstd * g * (sc + 1.0f) + sh;
            v2u w; w.x = pk2(h.x, h.y); w.y = pk2(h.z, h.w); o8[64 * j] = w; }
    }
}
__device__ __forceinline__ void norm1_phase(Frame& F) {
    const int gw = F.vcu * NWAVES + F.wave, NGW = F.G * NWAVES;
    for (int m = gw; m < M; m += NGW) {
        const int b = m / SEQ; const float* mod = F.MOD + b * NMOD;
        const GAS f32x4* xr = (const GAS f32x4*)(F.x + (size_t)m * D) + F.lane;
        const GAS v2u* yr = (const GAS v2u*)(F.Y + (size_t)m * D) + F.lane;
        f32x4 y[4]; float s = 0.f;
#pragma unroll
        for (int j = 0; j < 4; ++j) { const v2u w = yr[64 * j]; y[j] = (f32x4){bflo(w.x), bfhi(w.x), bflo(w.y), bfhi(w.y)};
            s += (y[j].x * y[j].x + y[j].y * y[j].y) + (y[j].z * y[j].z + y[j].w * y[j].w); }
        const float rstd = 1.0f / sqrtf(wave_sum(s) * (1.f / D) + NORM_EPS);
        f32x4 x1[4]; float s2 = 0.f;
        GAS f32x4* orow = (GAS f32x4*)(F.out + (size_t)m * D) + F.lane;
#pragma unroll
        for (int j = 0; j < 4; ++j) { const int col = 4 * F.lane + 256 * j;
            const f32x4 g = *(const f32x4*)(F.g_post_mix + col), gt = *(const f32x4*)(mod + 2 * D + col);
            x1[j] = xr[64 * j] + gt * (y[j] * rstd * g); orow[64 * j] = x1[j];
            s2 += (x1[j].x * x1[j].x + x1[j].y * x1[j].y) + (x1[j].z * x1[j].z + x1[j].w * x1[j].w); }
        const float rstd2 = 1.0f / sqrtf(wave_sum(s2) * (1.f / D) + NORM_EPS);
        GAS v2u* o8 = (GAS v2u*)(F.XN + (size_t)m * D) + F.lane;
#pragma unroll
        for (int j = 0; j < 4; ++j) { const int col = 4 * F.lane + 256 * j;
            const f32x4 g = *(const f32x4*)(F.g_pre_ffn + col), sh = *(const f32x4*)(mod + 3 * D + col), sc = *(const f32x4*)(mod + 4 * D + col);
            const f32x4 h = x1[j] * rstd2 * g * (sc + 1.0f) + sh;
            v2u w; w.x = pk2(h.x, h.y); w.y = pk2(h.z, h.w); o8[64 * j] = w; }
    }
}
__device__ __forceinline__ void norm2_phase(Frame& F) {
    const int gw = F.vcu * NWAVES + F.wave, NGW = F.G * NWAVES;
    for (int m = gw; m < M; m += NGW) {
        const int b = m / SEQ; const float* mod = F.MOD + b * NMOD;
        const GAS v2u* yr = (const GAS v2u*)(F.Y + (size_t)m * D) + F.lane;
        f32x4 y[4]; float s = 0.f;
#pragma unroll
        for (int j = 0; j < 4; ++j) { const v2u w = yr[64 * j]; y[j] = (f32x4){bflo(w.x), bfhi(w.x), bflo(w.y), bfhi(w.y)};
            s += (y[j].x * y[j].x + y[j].y * y[j].y) + (y[j].z * y[j].z + y[j].w * y[j].w); }
        const float rstd = 1.0f / sqrtf(wave_sum(s) * (1.f / D) + NORM_EPS);
        GAS f32x4* orow = (GAS f32x4*)(F.out + (size_t)m * D) + F.lane;
#pragma unroll
        for (int j = 0; j < 4; ++j) { const int col = 4 * F.lane + 256 * j;
            const f32x4 g = *(const f32x4*)(F.g_post_ffn + col), gt = *(const f32x4*)(mod + 5 * D + col);
            orow[64 * j] = orow[64 * j] + gt * (y[j] * rstd * g); }
    }
}

template <class Epi> __device__ __forceinline__ void sgemm_phase(Frame& F, const bf16* A, const bf16* Bt, int Mr, int N, int K, const Epi& E) {
    const int gw = F.vcu * NWAVES + F.wave, NGW = F.G * NWAVES;
    const int ntn = N / 64, nit = (Mr / 16) * ntn;
    const int lr = F.lane & 15, kq = (F.lane >> 4) * 8;
    for (int it = gw; it < nit; it += NGW) {
        const int rt = it / ntn, ct = it % ntn;
        const bf16* ap = A + (size_t)(rt * 16 + lr) * K + kq;
        const bf16* bp = Bt + (size_t)(ct * 64 + lr) * K + kq;
        f32x4 acc[4];
#pragma unroll
        for (int j = 0; j < 4; ++j) acc[j] = (f32x4){0.f, 0.f, 0.f, 0.f};
#pragma unroll 4
        for (int k0 = 0; k0 < K; k0 += 32) {
            const bf16x8 a = *(const bf16x8*)(ap + k0);
#pragma unroll
            for (int j = 0; j < 4; ++j) { const bf16x8 bv = *(const bf16x8*)(bp + (size_t)(16 * j) * K + k0);
                acc[j] = __builtin_amdgcn_mfma_f32_16x16x32_bf16(a, bv, acc[j], 0, 0, 0); }
        }
        E(acc, rt, ct, F.lane);
    }
}
struct SEpiStore { bf16* O; int ldc;
    __device__ __forceinline__ void operator()(const f32x4 (&acc)[4], int rt, int ct, int lane) const {
#pragma unroll
        for (int e = 0; e < 4; ++e) { const int row = rt * 16 + (lane >> 4) * 4 + e;
#pragma unroll
            for (int j = 0; j < 4; ++j) O[(size_t)row * ldc + ct * 64 + 16 * j + (lane & 15)] = (bf16)f2bf(acc[j][e]); }
    }
};
__device__ __forceinline__ int prow_of(int s, int sh) { return ((s & ((1 << sh) - 1)) << (12 - sh)) + (s >> sh); }
struct SEpiQKV { bf16 *U, *Q, *K, *V; const float* rope;
    __device__ __forceinline__ void operator()(const f32x4 (&acc)[4], int rt, int ct, int lane) const {
        const int col0 = ct * 64;
        if (col0 < POOLW) {
#pragma unroll
            for (int e = 0; e < 4; ++e) { const int row = rt * 16 + (lane >> 4) * 4 + e;
#pragma unroll
                for (int j = 0; j < 4; ++j) U[(size_t)row * POOLW + col0 + 16 * j + (lane & 15)] = (bf16)f2bf(acc[j][e]); }
            return;
        }
        const int c = col0 - POOLW, part = c / AW, hh = (c % AW) / HD, sh = 2 * (hh >> 2);
        bf16* dst = Q + (size_t)part * ((WS_K - WS_Q) / 2);
#pragma unroll
        for (int e = 0; e < 4; ++e) { const int row = rt * 16 + (lane >> 4) * 4 + e, b = row / SEQ, s = row % SEQ;
            const size_t base = ((size_t)(b * NH + hh) * SEQ + prow_of(s, sh)) * HD;
#pragma unroll
            for (int j = 0; j < 4; ++j) { const int dd = 16 * j + (lane & 15); float v = acc[j][e];
                if (j == 0 && part < 2) { const float partner = __shfl_xor(v, 8); const int jj = dd & 7;
                    const float cs = rope[row * 16 + jj], sn = rope[row * 16 + 8 + jj];
                    v = (dd < 8) ? (v * cs - partner * sn) : (v * cs + partner * sn); }
                if (part == 0) v *= QSCALE;
                dst[base + dd] = (bf16)f2bf(v); } }
    }
};
__device__ __forceinline__ float gelu_tanh(float x) {
    const float u = 0.7978845608028654f * (x + 0.044715f * x * x * x);
    const float t = 1.0f - 2.0f / (__expf(2.0f * u) + 1.0f);
    return 0.5f * x * (1.0f + t);
}
__device__ __forceinline__ void sgemm_up_phase(Frame& F) {
    const int gw = F.vcu * NWAVES + F.wave, NGW = F.G * NWAVES;
    constexpr int ntn = DFF / 16, nit = (M / 16) * ntn, K = D;
    const int lr = F.lane & 15, kq = (F.lane >> 4) * 8;
    for (int it = gw; it < nit; it += NGW) {
        const int rt = it / ntn, ct = it % ntn;
        const int arow = rt * 16 + lr, as = arow % SEQ;
        const bf16* ap = F.XN + (size_t)arow * K + kq;
        const int gcol = ct * 16 + lr;
        const bf16* bg = F.WUP + (size_t)(256 * (gcol >> 7) + (gcol & 127)) * K + kq;
        const bf16* bv = bg + (size_t)128 * K;
        f32x4 g0 = {0.f, 0.f, 0.f, 0.f}, g1 = g0, g2 = g0, vv = g0;
        const bf16x8 zero = {0, 0, 0, 0, 0, 0, 0, 0};
#pragma unroll 2
        for (int k0 = 0; k0 < K; k0 += 32) {
            const bf16x8 a0 = *(const bf16x8*)(ap + k0);
            const bf16x8 a1 = as >= 1 ? *(const bf16x8*)(ap - K + k0) : zero;
            const bf16x8 a2 = as >= 2 ? *(const bf16x8*)(ap - 2 * K + k0) : zero;
            const bf16x8 wg = *(const bf16x8*)(bg + k0), wv = *(const bf16x8*)(bv + k0);
            g0 = __builtin_amdgcn_mfma_f32_16x16x32_bf16(a0, wg, g0, 0, 0, 0);
            g1 = __builtin_amdgcn_mfma_f32_16x16x32_bf16(a1, wg, g1, 0, 0, 0);
            g2 = __builtin_amdgcn_mfma_f32_16x16x32_bf16(a2, wg, g2, 0, 0, 0);
            vv = __builtin_amdgcn_mfma_f32_16x16x32_bf16(a0, wv, vv, 0, 0, 0);
        }
        const float w0 = F.conv_w[gcol], w1 = F.conv_w[DFF + gcol], w2 = F.conv_w[2 * DFF + gcol], cb = F.conv_b[gcol];
#pragma unroll
        for (int e = 0; e < 4; ++e) { const int row = rt * 16 + (F.lane >> 4) * 4 + e;
            const float gate = w0 * g2[e] + w1 * g1[e] + w2 * g0[e] + cb;
            F.ACT[(size_t)row * DFF + gcol] = (bf16)f2bf(gelu_tanh(gate) * vv[e]); }
    }
}

__device__ __forceinline__ float dot64(const v4u (&q)[8], const bf16* krow) {
    float s = 0.f;
#pragma unroll
    for (int i = 0; i < 8; ++i) { const v4u k = *(const v4u*)(krow + 8 * i);
        s += bflo(q[i].x) * bflo(k.x) + bfhi(q[i].x) * bfhi(k.x) + bflo(q[i].y) * bflo(k.y) + bfhi(q[i].y) * bfhi(k.y)
           + bflo(q[i].z) * bflo(k.z) + bfhi(q[i].z) * bfhi(k.z) + bflo(q[i].w) * bflo(k.w) + bfhi(q[i].w) * bfhi(k.w); }
    return s;
}
__device__ __forceinline__ void sattn_phase(Frame& F) {
    const int gw = F.vcu * NWAVES + F.wave, NGW = F.G * NWAVES;
    for (int it = gw; it < M * 4; it += NGW) {
        const int row = it >> 2, hs = it & 3, b = row / SEQ, s = row % SEQ;
        float m = -INFINITY, l = 0.f, acc = 0.f;
#pragma unroll
        for (int g = 0; g < 3; ++g) { const int sh = 2 * g, head = g * 4 + hs;
            const int i = s >> sh, nk = (i < 128 ? i : 128) + 1;
            const size_t qrow = (size_t)(b * NH + head) * SEQ + prow_of(s, sh);
            v4u q[8];
#pragma unroll
            for (int j = 0; j < 8; ++j) q[j] = *(const v4u*)(F.Q + qrow * HD + 8 * j);
            float sc[3];
#pragma unroll
            for (int t = 0; t < 3; ++t) { const int k = F.lane + 64 * t; sc[t] = (k < nk) ? dot64(q, F.K + (qrow - k) * HD) : -INFINITY; }
            const float gm = wave_max(fmaxf(fmaxf(sc[0], sc[1]), sc[2]));
            const float mn = fmaxf(m, gm), alpha = exp2f(m - mn);
            float p[3];
#pragma unroll
            for (int t = 0; t < 3; ++t) p[t] = exp2f(sc[t] - mn);
            l = l * alpha + wave_sum(p[0] + p[1] + p[2]); acc *= alpha; m = mn;
            const bf16* vp = F.V + qrow * HD + F.lane;
#pragma unroll
            for (int t = 0; t < 3; ++t) { const int kend = nk - 64 * t < 64 ? nk - 64 * t : 64;
                for (int kk = 0; kk < kend; ++kk) { const float pk = __shfl(p[t], kk); acc += pk * bf2f(vp[-(long)(64 * t + kk) * HD]); } }
        }
        F.MIX[(size_t)row * NMIX + POOLW + hs * HD + F.lane] = (bf16)f2bf(acc / l);
    }
}
__device__ __forceinline__ void spool_phase(Frame& F) {
    const int gw = F.vcu * NWAVES + F.wave, NGW = F.G * NWAVES;
    for (int row = gw; row < M; row += NGW) { const int s = row % SEQ;
#pragma unroll
        for (int gi = 0; gi < 4; ++gi) { const int w = 2 << gi, cnt = (s + 1 < w) ? s + 1 : w;
            const bf16* up = F.U + (size_t)row * POOLW + gi * 64 + F.lane;
            float sum = 0.f;
            for (int j = 0; j < cnt; ++j) sum += bf2f(up[-(long)j * POOLW]);
            const float mixed = sum / (float)cnt - bf2f(up[0]);
            float y = F.b_pool[gi * 64 + F.lane];
            const float* wp = F.w_pool + (size_t)gi * 64 * 64 + F.lane;
#pragma unroll 8
            for (int c = 0; c < 64; ++c) y += __shfl(mixed, c) * wp[c * 64];
            F.MIX[(size_t)row * NMIX + gi * 64 + F.lane] = (bf16)f2bf(y * F.pool_scale[gi * 64 + F.lane]); }
    }
}


namespace fattn {
typedef float f32x16 __attribute__((ext_vector_type(16)));
typedef short v4i16_t __attribute__((ext_vector_type(4)));
__device__ __forceinline__ int crow(int r, int hi) { return (r & 3) + 8 * (r >> 2) + 4 * hi; }
__device__ __forceinline__ unsigned cvtpk(float lo, float hi) { unsigned r; asm volatile("v_cvt_pk_bf16_f32 %0, %1, %2" : "=v"(r) : "v"(lo), "v"(hi)); return r; }
__device__ __forceinline__ v4i16_t vtr(LAS const unsigned char* p) { return __builtin_amdgcn_ds_read_tr16_b64_v4i16((LAS v4i16_t*)p); }
template <int G_> __device__ __forceinline__ void attn_item(Frame& F, int b, int hs, int T0, int j, LAS unsigned char* vbuf, float* scrO, float* scrML) {
    constexpr int sh = 2 * G_;
    const int lane = F.lane, r32 = lane & 31, hi = lane >> 5;
    const int head = 4 * G_ + hs;
    int cls, i0, tk;
    if (G_ == 0) { cls = 0; i0 = T0 + 32 * j; tk = 32 * j + r32; }
    else if (G_ == 1) { cls = j >> 2; i0 = (T0 >> 2) + 32 * (j & 3); tk = 4 * (32 * (j & 3) + r32) + cls; }
    else { cls = j; i0 = T0 >> 4; tk = 16 * r32 + cls; }
    const int kt_lo = i0 >= 128 ? 0 : (128 - i0) >> 5;
    const size_t prow0 = (size_t)(b * NH + head) * SEQ + (size_t)cls * (SEQ >> sh);
    const bf16* Qp = F.Q + (prow0 + i0 + r32) * HD + 8 * hi;
    const bf16* Kb = F.K + ((long)prow0 + i0 - 128 + r32) * HD + 8 * hi;
    const bf16* Vb = F.V + ((long)prow0 + i0 - 128) * HD;
    bf16x8 qf[4];
#pragma unroll
    for (int ks = 0; ks < 4; ++ks) qf[ks] = *(const bf16x8*)(Qp + 16 * ks);
    f32x16 S[5];
#pragma unroll
    for (int kt = 0; kt < 5; ++kt) {
        if (kt >= kt_lo) {
            const bf16* kr = Kb + (size_t)(32 * kt) * HD;
            bf16x8 kf[4];
#pragma unroll
            for (int ks = 0; ks < 4; ++ks) kf[ks] = *(const bf16x8*)(kr + 16 * ks);
            f32x16 acc = {0.f, 0.f, 0.f, 0.f, 0.f, 0.f, 0.f, 0.f, 0.f, 0.f, 0.f, 0.f, 0.f, 0.f, 0.f, 0.f};
#pragma unroll
            for (int ks = 0; ks < 4; ++ks) acc = __builtin_amdgcn_mfma_f32_32x32x16_bf16(kf[ks], qf[ks], acc, 0, 0, 0);
            S[kt] = acc;
        } else {
#pragma unroll
            for (int r = 0; r < 16; ++r) S[kt][r] = -INFINITY;
        }
    }
#pragma unroll
    for (int r = 0; r < 16; ++r) { const int kr = crow(r, hi); if (kr < r32) S[0][r] = -INFINITY; if (kr > r32) S[4][r] = -INFINITY; }
    float m = -INFINITY;
#pragma unroll
    for (int kt = 0; kt < 5; ++kt)
#pragma unroll
        for (int r = 0; r < 16; ++r) m = fmaxf(m, S[kt][r]);
    m = fmaxf(m, __shfl_xor(m, 32));
    float l = 0.f;
#pragma unroll
    for (int kt = 0; kt < 5; ++kt)
#pragma unroll
        for (int r = 0; r < 16; ++r) { const float p = __builtin_amdgcn_exp2f(S[kt][r] - m); S[kt][r] = p; l += p; }
    l += __shfl_xor(l, 32);
    f32x16 o[2];
#pragma unroll
    for (int r = 0; r < 16; ++r) { o[0][r] = 0.f; o[1][r] = 0.f; }
    const int q4 = (lane & 15) >> 2, p4 = lane & 3, gq = (lane >> 4) & 1;
    LAS const unsigned char* vrd = vbuf + (4 * hi + q4) * 64 + (16 * gq + 4 * p4) * 2;
#pragma unroll
    for (int kt = 0; kt < 5; ++kt) {
        if (kt >= kt_lo) {
            v4u vv[4];
#pragma unroll
            for (int it = 0; it < 4; ++it) { const int c = it * 64 + lane, key = c >> 3, ch = c & 7; vv[it] = *(const v4u*)(Vb + (size_t)(32 * kt + key) * HD + ch * 8); }
#pragma unroll
            for (int it = 0; it < 4; ++it) { const int c = it * 64 + lane, key = c >> 3, ch = c & 7; *(LAS v4u*)(vbuf + (ch >> 2) * 2048 + key * 64 + (ch & 3) * 16) = vv[it]; }
#pragma unroll
            for (int sx = 0; sx < 2; ++sx) {
                v4u pw; pw.x = cvtpk(S[kt][8 * sx + 0], S[kt][8 * sx + 1]); pw.y = cvtpk(S[kt][8 * sx + 2], S[kt][8 * sx + 3]);
                        pw.z = cvtpk(S[kt][8 * sx + 4], S[kt][8 * sx + 5]); pw.w = cvtpk(S[kt][8 * sx + 6], S[kt][8 * sx + 7]);
                const bf16x8 pb = __builtin_bit_cast(bf16x8, pw);
#pragma unroll
                for (int half = 0; half < 2; ++half) {
                    const v4i16_t lo = vtr(vrd + half * 2048 + (16 * sx) * 64), hi4 = vtr(vrd + half * 2048 + (16 * sx + 8) * 64);
                    const bf16x8 va = {lo[0], lo[1], lo[2], lo[3], hi4[0], hi4[1], hi4[2], hi4[3]};
                    o[half] = __builtin_amdgcn_mfma_f32_32x32x16_bf16(va, pb, o[half], 0, 0, 0);
                }
            }
        }
    }
    float* so = scrO + (size_t)tk * HD + 4 * hi;
    float* sml = scrML + (size_t)tk * 2;
    if (G_ == 0) {
#pragma unroll
        for (int half = 0; half < 2; ++half)
#pragma unroll
            for (int rg = 0; rg < 4; ++rg) *(f32x4*)(so + 32 * half + 8 * rg) = (f32x4){o[half][4 * rg], o[half][4 * rg + 1], o[half][4 * rg + 2], o[half][4 * rg + 3]};
        if (hi == 0) { sml[0] = m; sml[1] = l; }
    } else {
        const float mo = sml[0], lo_ = sml[1];
        const float mn = fmaxf(mo, m), a = __builtin_amdgcn_exp2f(mo - mn), bsc = __builtin_amdgcn_exp2f(m - mn);
        const float ln = lo_ * a + l * bsc;
        if (G_ == 1) {
#pragma unroll
            for (int half = 0; half < 2; ++half)
#pragma unroll
                for (int rg = 0; rg < 4; ++rg) { f32x4* p = (f32x4*)(so + 32 * half + 8 * rg); const f32x4 old = *p;
                    *p = old * a + (f32x4){o[half][4 * rg], o[half][4 * rg + 1], o[half][4 * rg + 2], o[half][4 * rg + 3]} * bsc; }
            if (hi == 0) { sml[0] = mn; sml[1] = ln; }
        } else {
            const float inv = 1.0f / ln;
            bf16* mp = F.MIX + ((size_t)b * SEQ + T0 + tk) * NMIX + POOLW + hs * HD + 4 * hi;
#pragma unroll
            for (int half = 0; half < 2; ++half)
#pragma unroll
                for (int rg = 0; rg < 4; ++rg) { const f32x4 old = *(const f32x4*)(so + 32 * half + 8 * rg);
                    const f32x4 v = (old * a + (f32x4){o[half][4 * rg], o[half][4 * rg + 1], o[half][4 * rg + 2], o[half][4 * rg + 3]} * bsc) * inv;
                    v2u w; w.x = cvtpk(v[0], v[1]); w.y = cvtpk(v[2], v[3]); *(v2u*)(mp + 32 * half + 8 * rg) = w; }
        }
    }
}
template <int GI> __device__ __forceinline__ void pool_item(Frame& F, int tile) {
    constexpr int W = 2 << GI;
    const int lane = F.lane, r32 = lane & 31, hi = lane >> 5;
    const int row = 32 * tile + r32, s = row & (SEQ - 1), cnt = (s + 1 < W) ? s + 1 : W;
    const float inv = 1.0f / (float)cnt;
    bf16x8 af[4];
#pragma unroll
    for (int ks = 0; ks < 4; ++ks) {
        const bf16* up = F.U + (size_t)row * POOLW + GI * 64 + 16 * ks + 8 * hi;
        float sum[8];
#pragma unroll
        for (int e = 0; e < 8; ++e) sum[e] = 0.f;
#pragma unroll
        for (int jj = 0; jj < W; ++jj) if (jj < cnt) { const v4u v = *(const v4u*)(up - (size_t)jj * POOLW);
            sum[0] += bflo(v.x); sum[1] += bfhi(v.x); sum[2] += bflo(v.y); sum[3] += bfhi(v.y); sum[4] += bflo(v.z); sum[5] += bfhi(v.z); sum[6] += bflo(v.w); sum[7] += bfhi(v.w); }
        const v4u cv = *(const v4u*)up;
        v4u pw; pw.x = cvtpk(sum[0] * inv - bflo(cv.x), sum[1] * inv - bfhi(cv.x)); pw.y = cvtpk(sum[2] * inv - bflo(cv.y), sum[3] * inv - bfhi(cv.y));
                pw.z = cvtpk(sum[4] * inv - bflo(cv.z), sum[5] * inv - bfhi(cv.z)); pw.w = cvtpk(sum[6] * inv - bflo(cv.w), sum[7] * inv - bfhi(cv.w));
        af[ks] = __builtin_bit_cast(bf16x8, pw);
    }
#pragma unroll
    for (int nh = 0; nh < 2; ++nh) {
        const int dcol = GI * 64 + 32 * nh + r32;
        const bf16* wp = F.WPT + (size_t)dcol * 64 + 8 * hi;
        f32x16 acc = {0.f, 0.f, 0.f, 0.f, 0.f, 0.f, 0.f, 0.f, 0.f, 0.f, 0.f, 0.f, 0.f, 0.f, 0.f, 0.f};
#pragma unroll
        for (int ks = 0; ks < 4; ++ks) acc = __builtin_amdgcn_mfma_f32_32x32x16_bf16(af[ks], *(const bf16x8*)(wp + 16 * ks), acc, 0, 0, 0);
        const float bias = F.b_pool[dcol], sc = F.pool_scale[dcol];
#pragma unroll
        for (int r = 0; r < 16; ++r) F.MIX[(size_t)(32 * tile + crow(r, hi)) * NMIX + dcol] = (bf16)f2bf((acc[r] + bias) * sc);
    }
}
__device__ __forceinline__ void phase(Frame& F) {
    LAS unsigned char* vbuf = F.lds + RING_OFF + F.wave * 4096;
    for (int unit = F.vcu; unit < BATCH * 4 * 8; unit += F.G) {
        const int c = unit & 7, hs = (unit >> 3) & 3, b = unit >> 5, T0 = 512 * c;
        float* scrO = F.SCRO + (size_t)unit * 512 * HD; float* scrML = F.SCRML + (size_t)unit * 512 * 2;
        for (int k = 0; k < 2; ++k) attn_item<0>(F, b, hs, T0, F.wave + 8 * k, vbuf, scrO, scrML);
        VM_WAIT(); __syncthreads();
        for (int k = 0; k < 2; ++k) attn_item<1>(F, b, hs, T0, F.wave + 8 * k, vbuf, scrO, scrML);
        VM_WAIT(); __syncthreads();
        for (int k = 0; k < 2; ++k) attn_item<2>(F, b, hs, T0, F.wave + 8 * k, vbuf, scrO, scrML);
        VM_WAIT(); __syncthreads();
    }
    const int gw = F.vcu * NWAVES + F.wave, NGW = F.G * NWAVES;
    for (int it = gw; it < (M / 32) * 4; it += NGW) { const int tile = it >> 2, gi = it & 3;
        if (gi == 0) pool_item<0>(F, tile); else if (gi == 1) pool_item<1>(F, tile); else if (gi == 2) pool_item<2>(F, tile); else pool_item<3>(F, tile); }
}
}

namespace pg8 {
#define PG8_LAS __attribute__((address_space(3)))
typedef unsigned short bf16_t;
typedef short bf16x8 __attribute__((ext_vector_type(8)));
typedef float f32x4 __attribute__((ext_vector_type(4)));
typedef unsigned u32x4 __attribute__((ext_vector_type(4)));
constexpr int BM = 256, BK = 64, HALF = 128, HTB = HALF * BK * 2  , STAGE_BYTES = 8 * HTB, NXCD = 8, WGM = 8;

__host__ __device__ __forceinline__ int lds_byte(int r, int c) { const int st = (r >> 4) * 2 + (c >> 5), rr = r & 15, cc = c & 31, ob = rr * 64 + cc * 2; return st * 1024 + (ob ^ (((ob >> 9) & 1) << 5)); }
__host__ __device__ __forceinline__ void stage_rc(int b, int& R, int& C) { const int st = b / 1024, sb = b % 1024, swz = sb ^ (((sb >> 9) & 1) << 5); R = (st >> 1) * 16 + swz / 64; C = (st & 1) * 32 + (swz % 64) / 2; }
__host__ __device__ __forceinline__ int perm32(int rho) { const int n = rho >> 4, i = rho & 15; return 8 * (i >> 2) + 4 * n + (i & 3); }

struct Unit { int pm, pn; };
struct Gemm { const bf16_t* A; const bf16_t* Bt; int M, N, K; };

struct StaticOrder {
    int nM, nN, nwg, G, c;
    __host__ __device__ void init(int M, int N, int G_, int c_) { nM = M / BM; nN = N / BM; nwg = nM * nN; G = G_; c = c_; }
    __host__ __device__ bool next(int i, Unit& u) const {
        const long L = (long)i * G + c; if (L >= nwg) return false;
        int wgid = (int)L; { const int q = nwg / NXCD, r = nwg % NXCD, xcd = wgid % NXCD, off = wgid / NXCD; wgid = (xcd < r ? xcd * (q + 1) : r * (q + 1) + (xcd - r) * q) + off; }
        const int nig = WGM * nN, gid = wgid / nig, fm = gid * WGM, gsz = (nM - fm) < WGM ? (nM - fm) : WGM;
        u.pm = fm + ((wgid % nig) % gsz); u.pn = (wgid % nig) / gsz; return true;
    }
    __device__ __forceinline__ void a_ready(const Unit&) const {}
    __device__ __forceinline__ void done(const Unit&) const {}
};

typedef float f32x2 __attribute__((ext_vector_type(2)));
__device__ __forceinline__ unsigned cvt_pk_bf16(float lo, float hi) { unsigned r; asm volatile("v_cvt_pk_bf16_f32 %0, %1, %2" : "=v"(r) : "v"(lo), "v"(hi)); return r; }

__device__ __forceinline__ u32x4 pack8(const f32x4 v0, const f32x4 v1) { u32x4 w; w.x = cvt_pk_bf16(v0[0], v0[1]); w.y = cvt_pk_bf16(v0[2], v0[3]); w.z = cvt_pk_bf16(v1[0], v1[1]); w.w = cvt_pk_bf16(v1[2], v1[3]); return w; }
struct EpiStoreBf16 {
    static constexpr bool PERM = true, AFTER_DRAIN = false;
    bf16_t* O; int ldc;
    __device__ __forceinline__ void operator()(const f32x4 (&acc)[2][2][4][2], const Unit& u, int wr, int wc, int fr, int fq) const {
        const int row0 = u.pm * BM + wr * 64 + fr, col0 = u.pn * BM + wc * 32 + 8 * fq;
#pragma unroll
        for (int ai = 0; ai < 2; ++ai)
#pragma unroll
            for (int m = 0; m < 4; ++m) { bf16_t* rowp = O + (size_t)(row0 + ai * HALF + m * 16) * ldc + col0;
#pragma unroll
                for (int bj = 0; bj < 2; ++bj) *(u32x4*)(rowp + bj * HALF) = pack8(acc[ai][bj][m][0], acc[ai][bj][m][1]); }
    }
};
struct EpiQKV {
    static constexpr bool PERM = true, AFTER_DRAIN = false;
    bf16_t* U; bf16_t* Q; const float* rope;
    __device__ __forceinline__ void operator()(const f32x4 (&acc)[2][2][4][2], const Unit& u, int wr, int wc, int fr, int fq) const {
        const int row0 = u.pm * BM + wr * 64 + fr;
        if (u.pn == 0) {
#pragma unroll
            for (int ai = 0; ai < 2; ++ai)
#pragma unroll
                for (int m = 0; m < 4; ++m) { bf16_t* rowp = U + (size_t)(row0 + ai * HALF + m * 16) * POOLW + wc * 32 + 8 * fq;
#pragma unroll
                    for (int bj = 0; bj < 2; ++bj) *(u32x4*)(rowp + bj * HALF) = pack8(acc[ai][bj][m][0], acc[ai][bj][m][1]); }
            return;
        }
        const int t = u.pn - 1, part = t / 3, g = t % 3, sh = 2 * g;
        bf16_t* dst = Q + (size_t)part * ((WS_K - WS_Q) / 2);
        const bool rot = (part < 2) && ((wc & 1) == 0);
        const float sc = part == 0 ? QSCALE : 1.f;
        const float sgn = fq == 0 ? -1.f : 1.f; const bool actl = fq < 2;
#pragma unroll
        for (int ai = 0; ai < 2; ++ai)
#pragma unroll
            for (int m = 0; m < 4; ++m) { const int row = row0 + ai * HALF + m * 16, b = row >> 12, s = row & (SEQ - 1);
                f32x4 cs[2], sn[2];
                if (rot) {
#pragma unroll
                    for (int n = 0; n < 2; ++n) { cs[n] = *(const f32x4*)(rope + (size_t)row * 16 + 4 * n); sn[n] = *(const f32x4*)(rope + (size_t)row * 16 + 8 + 4 * n); } }
                const size_t rbase = ((size_t)b * NH * SEQ + prow_of(s, sh)) * HD + 32 * (wc & 1) + 8 * fq;
#pragma unroll
                for (int bj = 0; bj < 2; ++bj) { const int hh = 4 * g + 2 * bj + (wc >> 1);
                    f32x4 v[2] = {acc[ai][bj][m][0], acc[ai][bj][m][1]};
                    if (rot) {
#pragma unroll
                        for (int n = 0; n < 2; ++n)
#pragma unroll
                            for (int e = 0; e < 4; ++e) { const float p = __shfl_xor(v[n][e], 16); const float r = v[n][e] * cs[n][e] + sgn * p * sn[n][e]; v[n][e] = actl ? r : v[n][e]; } }
                    v[0] = v[0] * sc; v[1] = v[1] * sc;
                    *(u32x4*)(dst + rbase + (size_t)hh * SEQ * HD) = pack8(v[0], v[1]); } }
    }
};


template <int CTRL> __device__ __forceinline__ float dppf(float old, float src) {
    return __builtin_bit_cast(float, __builtin_amdgcn_update_dpp(__builtin_bit_cast(int, old), __builtin_bit_cast(int, src), CTRL, 0xF, 0xF, false)); }
__device__ __forceinline__ float gelu_fast(float x) {
    const float x2 = x * x, t = x * (-2.302208198f + (-0.1029432397f) * x2);
    return x * __builtin_amdgcn_rcpf(1.0f + __builtin_amdgcn_exp2f(t));
}
struct EpiUpAct {
    static constexpr bool PERM = true, AFTER_DRAIN = false;
    bf16_t* ACT; const float* conv_w; const float* conv_b; float* TAIL; float* HEAD; PG8_LAS float* XB;
    __device__ __forceinline__ void operator()(const f32x4 (&acc)[2][2][4][2], const Unit& u, int wr, int wc, int fr, int fq) const {
        const int cidx = wc * 32 + 8 * fq, gcol = u.pn * 128 + cidx;
        if (fr >= 14) {
#pragma unroll
            for (int ai = 0; ai < 2; ++ai)
#pragma unroll
                for (int n = 0; n < 2; ++n) *(PG8_LAS f32x4*)(XB + ((wr * 2 + ai) * 2 + (fr - 14)) * 128 + cidx + 4 * n) = acc[ai][0][3][n];
            if (wr == 1) {
#pragma unroll
                for (int n = 0; n < 2; ++n) *(f32x4*)(TAIL + ((size_t)u.pm * 2 + (fr - 14)) * DFF + gcol + 4 * n) = acc[1][0][3][n]; }
        }
        if (wr == 0 && fr < 2) {
#pragma unroll
            for (int n = 0; n < 2; ++n) { *(f32x4*)(HEAD + (((size_t)u.pm * 2 + fr) * 2 + 0) * DFF + gcol + 4 * n) = acc[0][0][0][n];
                                          *(f32x4*)(HEAD + (((size_t)u.pm * 2 + fr) * 2 + 1) * DFF + gcol + 4 * n) = acc[0][1][0][n]; }
        }
        asm volatile("s_waitcnt lgkmcnt(0)" ::: "memory"); __builtin_amdgcn_s_barrier(); asm volatile("" ::: "memory");
        f32x4 w0[2], w1[2], w2[2], cb[2];
#pragma unroll
        for (int n = 0; n < 2; ++n) { w0[n] = *(const f32x4*)(conv_w + gcol + 4 * n); w1[n] = *(const f32x4*)(conv_w + DFF + gcol + 4 * n);
            w2[n] = *(const f32x4*)(conv_w + 2 * DFF + gcol + 4 * n); cb[n] = *(const f32x4*)(conv_b + gcol + 4 * n); }
        const int row0 = u.pm * BM + wr * 64 + fr;
#pragma unroll
        for (int ai = 0; ai < 2; ++ai) {
            const int src = (wr == 1) ? ai : 2;
            f32x4 x1[2], x2[2];
#pragma unroll
            for (int n = 0; n < 2; ++n) { x1[n] = *(const PG8_LAS f32x4*)(XB + (src * 2 + 1) * 128 + cidx + 4 * n); x2[n] = *(const PG8_LAS f32x4*)(XB + (src * 2 + (fr & 1)) * 128 + cidx + 4 * n); }
#pragma unroll
            for (int m = 0; m < 4; ++m) {
                f32x4 res[2];
#pragma unroll
                for (int n = 0; n < 2; ++n) {
                    const f32x4 cur = acc[ai][0][m][n], val = acc[ai][1][m][n];
#pragma unroll
                    for (int e = 0; e < 4; ++e) {
                        float s1, s2;
                        if (m == 0) { s1 = dppf<0x111>(x1[n][e], cur[e]); s2 = dppf<0x112>(x2[n][e], cur[e]); }
                        else { const float p = acc[ai][0][m > 0 ? m - 1 : 0][n][e];
                               s1 = dppf<0x111>(dppf<0x121>(p, p), cur[e]); s2 = dppf<0x112>(dppf<0x122>(p, p), cur[e]); }
                        const float gate = w0[n][e] * s2 + w1[n][e] * s1 + w2[n][e] * cur[e] + cb[n][e];
                        res[n][e] = gelu_fast(gate) * val[e];
                    }
                }
                if (!(wr == 0 && ai == 0 && m == 0 && fr < 2))
                    *(u32x4*)(ACT + (size_t)(row0 + ai * HALF + m * 16) * DFF + gcol) = pack8(res[0], res[1]);
            }
        }
    }
};

template <class Epi, class Sched, bool ALIGN_EPI = false, bool SP2 = false>
__device__ __forceinline__ void gemm_phase(PG8_LAS unsigned char* lds, const Gemm g, const Sched& S, const Epi& E) {
    const int tid = threadIdx.x, wid = __builtin_amdgcn_readfirstlane(tid >> 6), lane = tid & 63, wr = wid >> 2, wc = wid & 3, fr = lane & 15, fq = lane >> 4;
    const int K = g.K, nt = K / BK;
    unsigned voffA[2], voffB[2];
#pragma unroll
    for (int i = 0; i < 2; ++i) { int R, C; stage_rc(tid * 16 + i * 8192, R, C); const int Rb = Epi::PERM ? ((R & ~31) + perm32(R & 31)) : R;
        voffA[i] = (unsigned)(R * K + C) * 2u; voffB[i] = (unsigned)(Rb * K + C) * 2u; }
    const size_t kstep = (size_t)(BK * 2);
    const size_t hstep = (size_t)HALF * K * 2;
    const size_t tstep = 2 * hstep;
    const unsigned ldsw = (unsigned)wid * 1024u;
    const int aoff = lds_byte(wr * 64 + fr, fq * 8), boff = lds_byte(wc * 32 + fr, fq * 8);
#define PG8_SA(b, h) (((b) * 2 + (h)) * HTB)
#define PG8_SB(b, h) ((4 + (b) * 2 + (h)) * HTB)
#define PG8_STAGE(bufoff, gbase, voff) do { _Pragma("unroll") for (int _i = 0; _i < 2; ++_i) \
        __builtin_amdgcn_global_load_lds((const unsigned*)((const char*)(gbase) + (voff)[_i]), (PG8_LAS unsigned*)(lds + (bufoff) + ldsw + _i * 8192), 16, 0, 0); } while (0)
#define PG8_LDA(dst, b, h) do { _Pragma("unroll") for (int m = 0; m < 4; ++m) _Pragma("unroll") for (int k = 0; k < 2; ++k) dst[m][k] = *(const PG8_LAS bf16x8*)(lds + PG8_SA(b, h) + aoff + m * 2048 + k * 1024); } while (0)
#define PG8_LDB(dst, b, h) do { _Pragma("unroll") for (int n = 0; n < 2; ++n) _Pragma("unroll") for (int k = 0; k < 2; ++k) dst[n][k] = *(const PG8_LAS bf16x8*)(lds + PG8_SB(b, h) + boff + n * 2048 + k * 1024); } while (0)
#define PG8_MMA(ai, bj, At, Bt) do { __builtin_amdgcn_s_setprio(1); _Pragma("unroll") for (int m = 0; m < 4; ++m) _Pragma("unroll") for (int n = 0; n < 2; ++n) _Pragma("unroll") for (int k = 0; k < 2; ++k) \
        acc[ai][bj][m][n] = __builtin_amdgcn_mfma_f32_16x16x32_bf16(Bt[n][k], At[m][k], acc[ai][bj][m][n], 0, 0, 0); __builtin_amdgcn_s_setprio(0); } while (0)
#define PG8_WAIT_V(n) asm volatile("s_waitcnt vmcnt(" #n ")" ::: "memory")
#define PG8_WAIT_L(n) asm volatile("s_waitcnt lgkmcnt(" #n ")" ::: "memory")
#define PG8_BAR __builtin_amdgcn_s_barrier()
#define PG8_SCHED __builtin_amdgcn_sched_barrier(0)
    Unit cur, nxt; int ui = 0;
    if (!S.next(0, cur)) return;
    f32x4 acc[2][2][4][2];
#pragma unroll
    for (int a = 0; a < 2; ++a)
#pragma unroll
        for (int b = 0; b < 2; ++b)
#pragma unroll
            for (int m = 0; m < 4; ++m)
#pragma unroll
                for (int n = 0; n < 2; ++n) acc[a][b][m][n] = (f32x4){0.f, 0.f, 0.f, 0.f};
    bf16x8 At[4][2], B0[2][2], B1[2][2];
    const char* cA = (const char*)g.A + (size_t)cur.pm * tstep; const char* cB = (const char*)g.Bt + (size_t)cur.pn * tstep;
    S.a_ready(cur);
    if constexpr (SP2) {
        PG8_STAGE(PG8_SB(0, 0), cB, voffB); PG8_STAGE(PG8_SB(0, 1), cB + hstep, voffB); PG8_STAGE(PG8_SA(0, 0), cA, voffA); PG8_STAGE(PG8_SA(0, 1), cA + hstep, voffA);
        if (wr == 1) PG8_BAR;
        PG8_WAIT_V(2); PG8_BAR;
        PG8_STAGE(PG8_SB(1, 0), cB + kstep, voffB); PG8_STAGE(PG8_SA(1, 0), cA + kstep, voffA); PG8_STAGE(PG8_SB(1, 1), cB + hstep + kstep, voffB);
        PG8_WAIT_V(6); PG8_BAR;
    } else {
        PG8_STAGE(PG8_SB(0, 0), cB, voffB); PG8_STAGE(PG8_SA(0, 0), cA, voffA); PG8_STAGE(PG8_SB(0, 1), cB + hstep, voffB); PG8_STAGE(PG8_SA(0, 1), cA + hstep, voffA);
        if (wr == 1) PG8_BAR;
        PG8_WAIT_V(4); PG8_BAR;
        PG8_STAGE(PG8_SB(1, 0), cB + kstep, voffB); PG8_STAGE(PG8_SA(1, 0), cA + kstep, voffA); PG8_STAGE(PG8_SB(1, 1), cB + hstep + kstep, voffB);
        PG8_WAIT_V(6); PG8_BAR;
    }
    for (;;) {
        const bool has_next = S.next(ui + 1, nxt);
        const char* nA = has_next ? (const char*)g.A + (size_t)nxt.pm * tstep : cA; const char* nB = has_next ? (const char*)g.Bt + (size_t)nxt.pn * tstep : cB;
        for (int t = 0; t < nt; t += 2) {
            const bool last = (t == nt - 2);
            const char* a1 = cA + (size_t)(t + 1) * kstep;
            const char* a2 = last ? nA : cA + (size_t)(t + 2) * kstep; const char* b2 = last ? nB : cB + (size_t)(t + 2) * kstep;
            const char* a3 = a2 + kstep; const char* b3 = b2 + kstep;
            if (last && has_next) S.a_ready(nxt);
            if constexpr (SP2) {
            PG8_LDB(B0, 0, 0); PG8_LDB(B1, 0, 1); PG8_SCHED; PG8_LDA(At, 0, 0); PG8_STAGE(PG8_SA(1, 1), a1 + hstep, voffA);
            PG8_WAIT_V(8); PG8_WAIT_L(0); PG8_BAR; PG8_MMA(0, 0, At, B0); PG8_MMA(0, 1, At, B1); PG8_BAR; PG8_SCHED;
            PG8_LDA(At, 0, 1); PG8_STAGE(PG8_SB(0, 0), b2, voffB); PG8_STAGE(PG8_SB(0, 1), b2 + hstep, voffB); PG8_STAGE(PG8_SA(0, 0), a2, voffA);
            PG8_WAIT_V(8); PG8_WAIT_L(0); PG8_BAR; PG8_MMA(1, 0, At, B0); PG8_MMA(1, 1, At, B1); PG8_BAR; PG8_SCHED;
            PG8_LDB(B0, 1, 0); PG8_LDB(B1, 1, 1); PG8_SCHED; PG8_LDA(At, 1, 0); PG8_STAGE(PG8_SA(0, 1), a2 + hstep, voffA);
            PG8_WAIT_V(8); PG8_WAIT_L(0); PG8_BAR; PG8_MMA(0, 0, At, B0); PG8_MMA(0, 1, At, B1); PG8_BAR; PG8_SCHED;
            PG8_LDA(At, 1, 1); PG8_STAGE(PG8_SB(1, 0), b3, voffB); PG8_STAGE(PG8_SB(1, 1), b3 + hstep, voffB); PG8_STAGE(PG8_SA(1, 0), a3, voffA);
            PG8_WAIT_V(8); PG8_WAIT_L(0); PG8_BAR; PG8_MMA(1, 0, At, B0); PG8_MMA(1, 1, At, B1); PG8_BAR; PG8_SCHED;
            } else {
            PG8_LDB(B0, 0, 0); PG8_SCHED; PG8_LDA(At, 0, 0); PG8_STAGE(PG8_SA(1, 1), a1 + hstep, voffA);
            PG8_WAIT_L(8); PG8_BAR; PG8_WAIT_L(0); PG8_MMA(0, 0, At, B0); PG8_BAR; PG8_SCHED;
            PG8_LDB(B1, 0, 1); PG8_STAGE(PG8_SB(0, 0), b2, voffB);
            PG8_BAR; PG8_WAIT_L(0); PG8_MMA(0, 1, At, B1); PG8_BAR;
            PG8_LDA(At, 0, 1); PG8_STAGE(PG8_SA(0, 0), a2, voffA);
            PG8_BAR; PG8_WAIT_L(0); PG8_MMA(1, 0, At, B0); PG8_BAR; PG8_SCHED;
            PG8_STAGE(PG8_SB(0, 1), b2 + hstep, voffB);
            PG8_WAIT_V(6); PG8_BAR; PG8_MMA(1, 1, At, B1); PG8_BAR;
            PG8_LDB(B0, 1, 0); PG8_SCHED; PG8_LDA(At, 1, 0); PG8_STAGE(PG8_SA(0, 1), a2 + hstep, voffA);
            PG8_WAIT_L(8); PG8_BAR; PG8_WAIT_L(0); PG8_MMA(0, 0, At, B0); PG8_BAR; PG8_SCHED;
            PG8_LDB(B1, 1, 1); PG8_STAGE(PG8_SB(1, 0), b3, voffB);
            PG8_BAR; PG8_WAIT_L(0); PG8_MMA(0, 1, At, B1); PG8_BAR;
            PG8_LDA(At, 1, 1); PG8_STAGE(PG8_SA(1, 0), a3, voffA);
            PG8_BAR; PG8_WAIT_L(0); PG8_MMA(1, 0, At, B0); PG8_BAR; PG8_SCHED;
            PG8_STAGE(PG8_SB(1, 1), b3 + hstep, voffB);
            PG8_WAIT_V(6); PG8_BAR; PG8_MMA(1, 1, At, B1); PG8_BAR;
            }
        }
        if constexpr (ALIGN_EPI) { if (wr == 0) PG8_BAR; }
        if constexpr (!Epi::AFTER_DRAIN) { E(acc, cur, wr, wc, fr, fq); S.done(cur); }
        if (!has_next) break;
#pragma unroll
        for (int a = 0; a < 2; ++a)
#pragma unroll
            for (int b = 0; b < 2; ++b)
#pragma unroll
                for (int m = 0; m < 4; ++m)
#pragma unroll
                    for (int n = 0; n < 2; ++n) acc[a][b][m][n] = (f32x4){0.f, 0.f, 0.f, 0.f};
        cur = nxt; cA = nA; cB = nB; ++ui;
        if constexpr (ALIGN_EPI) { if (wr == 1) PG8_BAR; }
    }
    PG8_WAIT_V(0);
    if constexpr (!ALIGN_EPI) { if (wr == 0) PG8_BAR; }
    PG8_BAR;
    if constexpr (Epi::AFTER_DRAIN) { E.fused(acc, cur, wr, wc, fr, fq, lds, wid, lane); S.done(cur); }
#undef PG8_SA
#undef PG8_SB
#undef PG8_STAGE
#undef PG8_LDA
#undef PG8_LDB
#undef PG8_MMA
#undef PG8_WAIT_V
#undef PG8_WAIT_L
#undef PG8_BAR
#undef PG8_SCHED
}
}


__device__ __forceinline__ void fixup_rows(Frame& F, int pm) {
    for (int idx = F.tid; idx < 2 * DFF; idx += NWAVES * 64) {
        const int r = idx / DFF, col = idx - r * DFF, t = pm * 256 + r, s = t & (SEQ - 1);
        const float g_t = F.HEAD[((size_t)(pm * 2 + r) * 2 + 0) * DFF + col], val = F.HEAD[((size_t)(pm * 2 + r) * 2 + 1) * DFF + col];
        float g1, g2;
        if (r == 0) { g1 = s >= 1 ? F.TAIL[((size_t)(pm - 1) * 2 + 1) * DFF + col] : 0.f; g2 = s >= 2 ? F.TAIL[((size_t)(pm - 1) * 2 + 0) * DFF + col] : 0.f; }
        else        { g1 = F.HEAD[((size_t)(pm * 2 + 0) * 2 + 0) * DFF + col];            g2 = s >= 2 ? F.TAIL[((size_t)(pm - 1) * 2 + 1) * DFF + col] : 0.f; }
        const float gate = F.conv_w[col] * g2 + F.conv_w[DFF + col] * g1 + F.conv_w[2 * DFF + col] * g_t + F.conv_b[col];
        F.ACT[(size_t)t * DFF + col] = (bf16)f2bf(pg8::gelu_fast(gate) * val);
    }
}
struct Args { const void* in[18]; float* out; unsigned char* ws; int ph_lo, ph_hi, use_bar, pad; };
__global__ void __launch_bounds__(NWAVES * 64, 2) mk_fwd(Args args) {
    extern __shared__ __attribute__((aligned(16))) unsigned char lds[];
    Frame F;
    F.lds = (LAS unsigned char*)lds;
    F.MISC = (volatile LAS unsigned*)(F.lds + MISC_OFF);
    F.tid = threadIdx.x; F.lane = F.tid & 63; F.wave = __builtin_amdgcn_readfirstlane(F.tid >> 6);
    F.G = gridDim.x; { const int bx = blockIdx.x; F.vcu = (F.G % 8 == 0) ? (bx % 8) * (F.G / 8) + bx / 8 : bx; }
    unsigned char* ws = args.ws;
    F.ctl = (gu32*)(ws + WS_CTL);
    F.x = (const float*)args.in[0]; F.c = (const float*)args.in[1]; F.pos = (const int*)args.in[2]; F.w_ada = (const float*)args.in[3]; F.b_ada = (const float*)args.in[4];
    F.g_pre_mix = (const float*)args.in[5]; F.g_post_mix = (const float*)args.in[6]; F.g_pre_ffn = (const float*)args.in[7]; F.g_post_ffn = (const float*)args.in[8];
    F.w_in = (const float*)args.in[9]; F.w_pool = (const float*)args.in[10]; F.b_pool = (const float*)args.in[11]; F.pool_scale = (const float*)args.in[12];
    F.w_out = (const float*)args.in[13]; F.w_up = (const float*)args.in[14]; F.conv_w = (const float*)args.in[15]; F.conv_b = (const float*)args.in[16]; F.w_down = (const float*)args.in[17];
    F.out = args.out;
    F.MOD = (float*)(ws + WS_MOD); F.ROPE = (float*)(ws + WS_ROPE);
    F.WIN = (bf16*)(ws + WS_WIN); F.WOUT = (bf16*)(ws + WS_WOUT); F.WUP = (bf16*)(ws + WS_WUP); F.WDOWN = (bf16*)(ws + WS_WDOWN);
    F.XN = (bf16*)(ws + WS_XN); F.U = (bf16*)(ws + WS_U); F.Q = (bf16*)(ws + WS_Q); F.K = (bf16*)(ws + WS_K); F.V = (bf16*)(ws + WS_V);
    F.MIX = (bf16*)(ws + WS_MIX); F.Y = (bf16*)(ws + WS_Y); F.ACT = (bf16*)(ws + WS_ACT); F.TAIL = (float*)(ws + WS_TAIL); F.HEAD = (float*)(ws + WS_HEAD); F.SCRO = (float*)(ws + WS_SCRO); F.SCRML = (float*)(ws + WS_SCRML); F.WPT = (bf16*)(ws + WS_WPT);
    for (int u = F.tid; u < (LDS_BYTES - LDSCTL_OFF) / 4; u += NWAVES * 64) ((LAS unsigned*)(F.lds + LDSCTL_OFF))[u] = 0u;
    __syncthreads();
    XcdBarrier bar; bar.bar = (unsigned*)(F.ctl + CW_BAR); bar.x = 0; bar.st = nullptr;
    if (args.use_bar) bar = xcd_barrier_post((unsigned*)(F.ctl + CW_BAR), F.MISC + 8);
    const int lo = args.ph_lo, hi = args.ph_hi;
#define IN(k) (lo <= (k) && (k) < hi)
#define SEAM(k) do { if (IN(k) && IN((k) + 1)) xcd_barrier(bar); } while (0)

    if (IN(0)) { p0a_phase(F); } SEAM(0);
    if (IN(1)) { p0b_phase(F); } SEAM(1);
    if (IN(2)) { pg8::Gemm g{F.XN, F.WIN, M, NIN, D}; pg8::StaticOrder S; S.init(M, NIN, F.G, (int)blockIdx.x); pg8::EpiQKV E{F.U, F.Q, F.ROPE};
                 pg8::gemm_phase<pg8::EpiQKV, pg8::StaticOrder, true, true>(F.lds + RING_OFF, g, S, E); } SEAM(2);
    if (IN(3)) { fattn::phase(F); } SEAM(3);
    if (IN(4)) { pg8::Gemm g{F.MIX, F.WOUT, M, D, NMIX}; pg8::StaticOrder S; S.init(M, D, F.G, (int)blockIdx.x); pg8::EpiStoreBf16 E{F.Y, D};
                 pg8::gemm_phase<pg8::EpiStoreBf16, pg8::StaticOrder, true, true>(F.lds + RING_OFF, g, S, E); } SEAM(4);
    if (IN(5)) { norm1_phase(F); } SEAM(5);
    if (IN(6)) { pg8::Gemm g{F.XN, F.WUP, M, NUP, D}; pg8::StaticOrder S; S.init(M, NUP, F.G, (int)blockIdx.x);
                 pg8::EpiUpAct E{F.ACT, F.conv_w, F.conv_b, F.TAIL, F.HEAD, (LAS float*)(F.lds + XB_OFF)};
                 pg8::gemm_phase<pg8::EpiUpAct, pg8::StaticOrder, true, true>(F.lds + RING_OFF, g, S, E); } SEAM(6);
    if (IN(7)) { pg8::Gemm g{F.ACT, F.WDOWN, M, D, DFF}; pg8::StaticOrder S; S.init(M, D, F.G, (int)blockIdx.x); pg8::EpiStoreBf16 E{F.Y, D};
                 { pg8::Unit uu; for (int i = 0; S.next(i, uu); ++i) fixup_rows(F, uu.pm); VM_WAIT(); __builtin_amdgcn_fence(__ATOMIC_ACQUIRE, "agent"); VM_WAIT(); __syncthreads(); }
                 pg8::gemm_phase<pg8::EpiStoreBf16, pg8::StaticOrder, true, true>(F.lds + RING_OFF, g, S, E); } SEAM(7);
    if (IN(8)) { norm2_phase(F); }
#undef IN
#undef SEAM
}

extern "C" void kernel_launch(void* const* d_in, const int* in_sizes, int n_in, void* d_out, int out_size, void* d_ws, size_t ws_size, hipStream_t stream) {
    static int grid = 0;
    if (grid == 0) {
        if (n_in != 18 || in_sizes[0] != M * D || out_size != M * D || ws_size < WS_END) {
            fprintf(stderr, "kernel_launch: unexpected shapes: n_in %d in0 %d out %d ws %zu\n", n_in, n_in > 0 ? in_sizes[0] : -1, out_size, ws_size); grid = -1; return; }
        int dev = 0, cus = 0, per_cu = 0;
        if (hipGetDevice(&dev) != hipSuccess || hipDeviceGetAttribute(&cus, hipDeviceAttributeMultiprocessorCount, dev) != hipSuccess) { grid = -1; return; }
        if (hipFuncSetAttribute((const void*)mk_fwd, hipFuncAttributeMaxDynamicSharedMemorySize, LDS_BYTES) != hipSuccess) { fprintf(stderr, "kernel_launch: hipFuncSetAttribute failed\n"); grid = -1; return; }
        if (hipOccupancyMaxActiveBlocksPerMultiprocessor(&per_cu, (const void*)mk_fwd, NWAVES * 64, LDS_BYTES) != hipSuccess || per_cu < 1)
            fprintf(stderr, "kernel_launch: occupancy query reports %d blocks per CU\n", per_cu);
        (void)hipGetLastError();
        grid = cus;
    }
    if (grid < 0) return;
    if (hipMemsetAsync((char*)d_ws + WS_CTL, 0, CTL_ZERO_BYTES, stream) != hipSuccess) return;
    Args a{};
    for (int i = 0; i < 18; ++i) a.in[i] = d_in[i];
    a.out = (float*)d_out; a.ws = (unsigned char*)d_ws;
#if MK_ONE_LAUNCH
    a.ph_lo = 0; a.ph_hi = NPHASE; a.use_bar = 1;
    hipLaunchKernelGGL(mk_fwd, dim3(grid), dim3(NWAVES * 64), LDS_BYTES, stream, a);
#else
    for (int p = 0; p < NPHASE; ++p) { a.ph_lo = p; a.ph_hi = p + 1; a.use_bar = 0;
        hipLaunchKernelGGL(mk_fwd, dim3(grid), dim3(NWAVES * 64), LDS_BYTES, stream, a); }
#endif
}
```
